# Optimizing an MI355X kernel written in HIP

```python
import jax, jax.numpy as jnp
from jax import lax
import numpy as np

D_MODEL = 2048
BATCH = 2
SEQ = 16384
DEPTH = 4

GRID_W = 64
CTX_LEN = 256
N_MIXERS = 3
N_A_LAYERS = (DEPTH + 2) // 3
N_B_LAYERS = (DEPTH + 1) // 3
N_C_LAYERS = DEPTH // 3
NA_HEADS = 16
NA_HEAD_DIM = D_MODEL // NA_HEADS
NA_WIN_ROWS = 8
NA_WIN_COLS = 16
MLA_HEADS = 16
MLA_Q_RANK = 512
MLA_KV_RANK = 512
MLA_NOPE_DIM = 128
MLA_ROPE_DIM = 64
MLA_V_DIM = 128
GQA_HEADS = 16
GQA_KV_HEADS = 4
GQA_HEAD_DIM = 128
FFN_DIM = 5632
CONV_WIDTH = 3
ROPE_THETA = 10000.0
Q_BLOCK = 128
NORM_EPS = 1e-6
ADA_INIT = 0.5

kernel_name = 'hybrid_na_mla_gqa_convglu_dit'


def rms_norm(x, g):
    xf = x.astype(jnp.float32)
    y = xf * lax.rsqrt(jnp.mean(xf * xf, axis=-1, keepdims=True) + NORM_EPS)
    return (y * g.astype(jnp.float32)).astype(x.dtype)


def axial_rope(n_tok, rot_dim, dtype):
    quarter = rot_dim // 4
    t = jnp.arange(n_tok)
    row = (t // GRID_W).astype(jnp.float32)
    col = (t % GRID_W).astype(jnp.float32)
    inv = ROPE_THETA ** (-jnp.arange(quarter, dtype=jnp.float32) / quarter)
    ar = row[:, None] * inv
    ac = col[:, None] * inv
    ang = jnp.concatenate([ar, ar, ac, ac], axis=-1)
    return jnp.cos(ang).astype(dtype), jnp.sin(ang).astype(dtype)


def rotate_half_axial(x):
    x0, x1, x2, x3 = jnp.split(x, 4, axis=-1)
    return jnp.concatenate([-x1, x0, -x3, x2], axis=-1)


def apply_rope(x, cos, sin):
    return x * cos[None, :, None, :] + rotate_half_axial(x) * sin[None, :, None, :]


def attend_blocks(q, k, v, kc, vc, scale):
    B, S, G, R, Dk = q.shape
    nb = S // Q_BLOCK
    qb = q.reshape(B, nb, Q_BLOCK, G, R, Dk).transpose(1, 0, 2, 3, 4, 5)

    def one_block(qblk):
        s_lat = jnp.einsum('bqgrd,bkgd->bgrqk', qblk, k)
        s_ctx = jnp.einsum('bqgrd,bcgd->bgrqc', qblk, kc)
        s = jnp.concatenate([s_lat, s_ctx], axis=-1).astype(jnp.float32) * scale
        p = jax.nn.softmax(s, axis=-1).astype(v.dtype)
        return (jnp.einsum('bgrqk,bkgd->bqgrd', p[..., :S], v)
                + jnp.einsum('bgrqc,bcgd->bqgrd', p[..., S:], vc))

    o = lax.map(one_block, qb)
    return o.transpose(1, 0, 2, 3, 4, 5).reshape(B, S, -1)


def dense_attend(q, k, v, scale):
    B, L = q.shape[:2]
    s = jnp.einsum('bqgrd,bkgd->bgrqk', q, k).astype(jnp.float32) * scale
    p = jax.nn.softmax(s, axis=-1).astype(v.dtype)
    return jnp.einsum('bgrqk,bkgd->bqgrd', p, v).reshape(B, L, -1)


def neighborhood_attend(q, k, v, kc, vc, rpb, rows):
    B, S, H, Dh = q.shape
    kr = min(NA_WIN_ROWS, rows)
    n_loc = kr * NA_WIN_COLS
    scale = Dh ** -0.5
    qg = q.reshape(B, rows, GRID_W, H, Dh)
    kg = k.reshape(B, rows, GRID_W, H, Dh)
    vg = v.reshape(B, rows, GRID_W, H, Dh)
    col = jnp.arange(GRID_W)
    cstart = jnp.clip(col - NA_WIN_COLS // 2, 0, GRID_W - NA_WIN_COLS)
    cidx = cstart[:, None] + jnp.arange(NA_WIN_COLS)[None, :]
    dc = cidx - col[:, None] + (NA_WIN_COLS - 1)

    def one_row(r):
        rstart = jnp.clip(r - kr // 2, 0, rows - kr)
        q_r = lax.dynamic_index_in_dim(qg, r, axis=1, keepdims=False)
        k_band = lax.dynamic_slice_in_dim(kg, rstart, kr, axis=1)
        v_band = lax.dynamic_slice_in_dim(vg, rstart, kr, axis=1)
        k_win = k_band[:, :, cidx]
        v_win = v_band[:, :, cidx]
        dr = rstart + jnp.arange(kr) - r + (NA_WIN_ROWS - 1)
        bias = rpb[:, dr[:, None, None], dc[None, :, :]].transpose(0, 2, 1, 3)
        s_loc = jnp.einsum('bqhd,bkqjhd->bhqkj', q_r, k_win).astype(jnp.float32) * scale
        s_loc = (s_loc + bias[None].astype(jnp.float32)).reshape(B, H, GRID_W, n_loc)
        s_ctx = jnp.einsum('bqhd,bchd->bhqc', q_r, kc).astype(jnp.float32) * scale
        p = jax.nn.softmax(jnp.concatenate([s_loc, s_ctx], axis=-1), axis=-1).astype(v.dtype)
        p_loc = p[..., :n_loc].reshape(B, H, GRID_W, kr, NA_WIN_COLS)
        return (jnp.einsum('bhqkj,bkqjhd->bqhd', p_loc, v_win)
                + jnp.einsum('bhqc,bchd->bqhd', p[..., n_loc:], vc))

    o = lax.map(one_row, jnp.arange(rows))
    return o.transpose(1, 0, 2, 3, 4).reshape(B, S, H, Dh)


def na_mixer(h, hc, wqkv, rpb, wo, rows, need_ctx):
    B, N, D = h.shape
    L = hc.shape[1]
    qkv = (h @ wqkv).reshape(B, N, 3, NA_HEADS, NA_HEAD_DIM)
    qkv_c = (hc @ wqkv).reshape(B, L, 3, NA_HEADS, NA_HEAD_DIM)
    kc, vc = qkv_c[:, :, 1], qkv_c[:, :, 2]
    o = neighborhood_attend(qkv[:, :, 0], qkv[:, :, 1], qkv[:, :, 2], kc, vc, rpb, rows)
    y = o.reshape(B, N, D) @ wo
    yc = None
    if need_ctx:
        oc = dense_attend(qkv_c[:, :, 0][:, :, :, None], kc, vc, NA_HEAD_DIM ** -0.5)
        yc = oc @ wo
    return y, yc


def mla_mixer(h, hc, wq_a, q_norm, wq_b, wkv_a, kv_norm, wkv_b, wo, cos, sin, need_ctx):
    def project(t, rot):
        B, N, _ = t.shape
        q = (rms_norm(t @ wq_a, q_norm) @ wq_b).reshape(B, N, MLA_HEADS, MLA_NOPE_DIM + MLA_ROPE_DIM)
        q_nope, q_pe = q[..., :MLA_NOPE_DIM], q[..., MLA_NOPE_DIM:]
        kv_a = t @ wkv_a
        c_kv, k_pe = kv_a[..., :MLA_KV_RANK], kv_a[..., MLA_KV_RANK:]
        kv = (rms_norm(c_kv, kv_norm) @ wkv_b).reshape(B, N, MLA_HEADS, MLA_NOPE_DIM + MLA_V_DIM)
        k_nope, v = kv[..., :MLA_NOPE_DIM], kv[..., MLA_NOPE_DIM:]
        k_pe = k_pe[:, :, None, :]
        if rot is not None:
            q_pe = apply_rope(q_pe, *rot)
            k_pe = apply_rope(k_pe, *rot)
        k_pe = jnp.broadcast_to(k_pe, (B, N, MLA_HEADS, MLA_ROPE_DIM))
        q = jnp.concatenate([q_nope, q_pe], axis=-1)[:, :, :, None]
        k = jnp.concatenate([k_nope, k_pe], axis=-1)
        return q, k, v

    scale = (MLA_NOPE_DIM + MLA_ROPE_DIM) ** -0.5
    q, k, v = project(h, (cos, sin))
    qc, kc, vc = project(hc, None)
    y = attend_blocks(q, k, v, kc, vc, scale) @ wo
    yc = dense_attend(qc, kc, vc, scale) @ wo if need_ctx else None
    return y, yc


def gqa_mixer(h, hc, wqkv, q_norm, k_norm, wo, cos, sin, need_ctx):
    rep = GQA_HEADS // GQA_KV_HEADS
    split = [GQA_HEADS * GQA_HEAD_DIM, (GQA_HEADS + GQA_KV_HEADS) * GQA_HEAD_DIM]

    def project(t, rot):
        B, N, _ = t.shape
        q, k, v = jnp.split(t @ wqkv, split, axis=-1)
        q = rms_norm(q.reshape(B, N, GQA_HEADS, GQA_HEAD_DIM), q_norm)
        k = rms_norm(k.reshape(B, N, GQA_KV_HEADS, GQA_HEAD_DIM), k_norm)
        v = v.reshape(B, N, GQA_KV_HEADS, GQA_HEAD_DIM)
        if rot is not None:
            q = apply_rope(q, *rot)
            k = apply_rope(k, *rot)
        return q.reshape(B, N, GQA_KV_HEADS, rep, GQA_HEAD_DIM), k, v

    scale = GQA_HEAD_DIM ** -0.5
    q, k, v = project(h, (cos, sin))
    qc, kc, vc = project(hc, None)
    y = attend_blocks(q, k, v, kc, vc, scale) @ wo
    yc = dense_attend(qc, kc, vc, scale) @ wo if need_ctx else None
    return y, yc


def dwconv_seq(u, w, b):
    n = u.shape[1]
    pad = CONV_WIDTH // 2
    up = jnp.pad(u, ((0, 0), (pad, pad), (0, 0)))
    y = b
    for tap in range(CONV_WIDTH):
        y = y + up[:, tap:tap + n] * w[tap]
    return y


def conv_glu(h, w_up, conv_w, conv_b, w_down):
    gate, val = jnp.split(h @ w_up, 2, axis=-1)
    return (jax.nn.silu(dwconv_seq(gate, conv_w, conv_b)) * val) @ w_down


def setup_inputs(seed: int = 0) -> dict:
    key = jax.random.key(seed)
    ks = jax.random.split(key, 32)
    D = D_MODEL

    def nrm(i, shape, scale):
        return jax.random.normal(ks[i], shape, jnp.float32) * scale

    def gain(i, shape):
        return 1.0 + nrm(i, shape, 0.02)

    return {
        'x': nrm(0, (BATCH, SEQ, D), 1.0),
        'c': nrm(1, (BATCH, D), 1.0),
        'ctx': nrm(2, (BATCH, CTX_LEN, D), 1.0),
        'c_ctx': nrm(3, (D,), 1.0),
        'ada_w': nrm(4, (DEPTH, D, 6 * D), ADA_INIT * D ** -0.5),
        'ada_b': nrm(5, (DEPTH, 6 * D), 0.01),
        'mix_norm': gain(6, (DEPTH, D)),
        'ffn_norm': gain(7, (DEPTH, D)),
        'ffn_up': nrm(8, (DEPTH, D, 2 * FFN_DIM), D ** -0.5),
        'ffn_conv_w': nrm(9, (DEPTH, CONV_WIDTH, FFN_DIM), CONV_WIDTH ** -0.5),
        'ffn_conv_b': nrm(10, (DEPTH, FFN_DIM), 0.01),
        'ffn_down': nrm(11, (DEPTH, FFN_DIM, D), FFN_DIM ** -0.5),
        'na_wqkv': nrm(12, (N_A_LAYERS, D, 3 * D), D ** -0.5),
        'na_rpb': nrm(13, (N_A_LAYERS, NA_HEADS, 2 * NA_WIN_ROWS - 1, 2 * NA_WIN_COLS - 1), 0.1),
        'na_wo': nrm(14, (N_A_LAYERS, D, D), D ** -0.5),
        'mla_wq_a': nrm(15, (N_B_LAYERS, D, MLA_Q_RANK), D ** -0.5),
        'mla_q_norm': gain(16, (N_B_LAYERS, MLA_Q_RANK)),
        'mla_wq_b': nrm(17, (N_B_LAYERS, MLA_Q_RANK, MLA_HEADS * (MLA_NOPE_DIM + MLA_ROPE_DIM)), MLA_Q_RANK ** -0.5),
        'mla_wkv_a': nrm(18, (N_B_LAYERS, D, MLA_KV_RANK + MLA_ROPE_DIM), D ** -0.5),
        'mla_kv_norm': gain(19, (N_B_LAYERS, MLA_KV_RANK)),
        'mla_wkv_b': nrm(20, (N_B_LAYERS, MLA_KV_RANK, MLA_HEADS * (MLA_NOPE_DIM + MLA_V_DIM)), MLA_KV_RANK ** -0.5),
        'mla_wo': nrm(21, (N_B_LAYERS, MLA_HEADS * MLA_V_DIM, D), (MLA_HEADS * MLA_V_DIM) ** -0.5),
        'gqa_wqkv': nrm(22, (N_C_LAYERS, D, (GQA_HEADS + 2 * GQA_KV_HEADS) * GQA_HEAD_DIM), D ** -0.5),
        'gqa_q_norm': gain(23, (N_C_LAYERS, GQA_HEAD_DIM)),
        'gqa_k_norm': gain(24, (N_C_LAYERS, GQA_HEAD_DIM)),
        'gqa_wo': nrm(25, (N_C_LAYERS, GQA_HEADS * GQA_HEAD_DIM, D), (GQA_HEADS * GQA_HEAD_DIM) ** -0.5),
        'final_norm': gain(26, (D,)),
    }


def reference(x, c, ctx, c_ctx, ada_w, ada_b, mix_norm, ffn_norm, ffn_up, ffn_conv_w, ffn_conv_b, ffn_down,
              na_wqkv, na_rpb, na_wo, mla_wq_a, mla_q_norm, mla_wq_b, mla_wkv_a, mla_kv_norm, mla_wkv_b, mla_wo,
              gqa_wqkv, gqa_q_norm, gqa_k_norm, gqa_wo, final_norm):
    n_tok = x.shape[1]
    rows = n_tok // GRID_W
    cos_b, sin_b = axial_rope(n_tok, MLA_ROPE_DIM, x.dtype)
    cos_c, sin_c = axial_rope(n_tok, GQA_HEAD_DIM, x.dtype)
    xc = ctx
    for i in range(DEPTH):
        last = i == DEPTH - 1
        mod = (jax.nn.silu(c) @ ada_w[i] + ada_b[i])[:, None, :]
        mod_c = jax.nn.silu(c_ctx) @ ada_w[i] + ada_b[i]
        sh1, sc1, g1, sh2, sc2, g2 = jnp.split(mod, 6, axis=-1)
        csh1, csc1, cg1, csh2, csc2, cg2 = jnp.split(mod_c, 6, axis=-1)
        h = rms_norm(x, mix_norm[i]) * (1 + sc1) + sh1
        hc = rms_norm(xc, mix_norm[i]) * (1 + csc1) + csh1
        kind, j = i % N_MIXERS, i // N_MIXERS
        if kind == 0:
            y, yc = na_mixer(h, hc, na_wqkv[j], na_rpb[j], na_wo[j], rows, not last)
        elif kind == 1:
            y, yc = mla_mixer(h, hc, mla_wq_a[j], mla_q_norm[j], mla_wq_b[j], mla_wkv_a[j], mla_kv_norm[j],
                              mla_wkv_b[j], mla_wo[j], cos_b, sin_b, not last)
        else:
            y, yc = gqa_mixer(h, hc, gqa_wqkv[j], gqa_q_norm[j], gqa_k_norm[j], gqa_wo[j],
                              cos_c, sin_c, not last)
        x = x + g1 * y
        hf = rms_norm(x, ffn_norm[i]) * (1 + sc2) + sh2
        x = x + g2 * conv_glu(hf, ffn_up[i], ffn_conv_w[i], ffn_conv_b[i], ffn_down[i])
        if not last:
            xc = xc + cg1 * yc
            hfc = rms_norm(xc, ffn_norm[i]) * (1 + csc2) + csh2
            xc = xc + cg2 * conv_glu(hfc, ffn_up[i], ffn_conv_w[i], ffn_conv_b[i], ffn_down[i])
    return rms_norm(x, final_norm)
```

```cpp
#include <hip/hip_runtime.h>
#include <cstdio>
#include <cstdint>

#ifndef MK_PER_PHASE
#define MK_PER_PHASE 0
#endif

#ifndef EN_MASK
#define EN_MASK 0xFFFFFFFFu
#endif
#define EN(b) ((EN_MASK >> (b)) & 1u)
#ifndef RP_MASK
#define RP_MASK 0u
#endif
#define RPT(b) (1 + (int)((ap->rep_mask >> (b)) & 1u))
#define LAS __attribute__((address_space(3)))
typedef unsigned short bf16_t;
typedef short bf16x8 __attribute__((ext_vector_type(8)));
typedef short s16x4 __attribute__((ext_vector_type(4)));
typedef float f32x4 __attribute__((ext_vector_type(4)));
typedef float f32x2 __attribute__((ext_vector_type(2)));
typedef float f32x16 __attribute__((ext_vector_type(16)));
typedef unsigned u32x4 __attribute__((ext_vector_type(4)));
typedef unsigned u32x2 __attribute__((ext_vector_type(2)));

constexpr int DM = 2048, NBATCH = 2, SEQ = 16384, CTXL = 256, GRIDW = 64;
constexpr int NLAT = NBATCH * SEQ;
constexpr int MROWS = NLAT + NBATCH * CTXL;
constexpr int FFD = 5632, DEPTH = 4, MODW = 6 * DM;
constexpr float NORM_EPS = 1e-6f;
constexpr float LOG2E = 1.4426950408889634f;
constexpr int NBLK64 = MROWS / 64;

constexpr size_t MiB = 1u << 20;
constexpr size_t WS_CTL = 0, CTL_ZERO_BYTES = 1 * MiB;
constexpr size_t WS_MODS = 1 * MiB;
constexpr size_t WS_TAB = 2 * MiB;
constexpr size_t WS_RS = 3 * MiB;
constexpr size_t WS_X = 4 * MiB;
constexpr size_t WS_H = 264 * MiB;
constexpr size_t WS_O = 394 * MiB;
constexpr size_t WS_BIG = 524 * MiB;
constexpr size_t WS_W = 1068 * MiB;
constexpr size_t WS_END = 1436 * MiB;
constexpr size_t BIG_QKV = 0;
constexpr size_t BIG_T1 = 0, BIG_Q = 82 * MiB, BIG_KV = 277 * MiB, BIG_KPE = 537 * MiB;
constexpr size_t BIG_ACT = 0, BIG_SIDE = 358 * MiB;
constexpr size_t SIDE_ARR = (size_t)NBLK64 * FFD;
constexpr size_t W_UP = 0, W_DN = 176 * MiB, W_NAQKV = 264 * MiB, W_NAWO = 312 * MiB, W_MLA1 = 328 * MiB, W_MLAQB = 333 * MiB,
                 W_MLAKVB = 336 * MiB, W_MLAWO = 340 * MiB, W_GQAQKV = 348 * MiB, W_GQAWO = 360 * MiB;
constexpr size_t W_UP_L = 44 * MiB, W_DN_L = 22 * MiB, W_NAQKV_L = 24 * MiB, W_NAWO_L = 8 * MiB;
constexpr int CW_BAR = 4096;

constexpr int RING_BYTES = 150528;
constexpr int LDSCTL_OFF = RING_BYTES, MISC_OFF = LDSCTL_OFF + 320, NATAB_OFF = LDSCTL_OFF + 1024;
constexpr int LDS_BYTES = RING_BYTES + 8192;

__device__ __forceinline__ unsigned cvt_pk_bf16(float lo, float hi) { unsigned r; asm volatile("v_cvt_pk_bf16_f32 %0, %1, %2" : "=v"(r) : "v"(lo), "v"(hi)); return r; }
__device__ __forceinline__ float bf_lo(unsigned w) { return __uint_as_float(w << 16); }
__device__ __forceinline__ float bf_hi(unsigned w) { return __uint_as_float(w & 0xffff0000u); }
__device__ __forceinline__ float bf2f(bf16_t b) { return __uint_as_float(((unsigned)b) << 16); }
__device__ __forceinline__ bf16_t f2bf(float f) { return (bf16_t)(cvt_pk_bf16(f, 0.f) & 0xffffu); }
__device__ __forceinline__ float wave_sum(float v) {
#pragma unroll
    for (int o = 1; o < 64; o <<= 1) v += __shfl_xor(v, o);
    return v;
}
__device__ __forceinline__ float silu_f(float c) { return c * __builtin_amdgcn_rcpf(1.0f + __builtin_amdgcn_exp2f(-c * LOG2E)); }
__device__ __forceinline__ int row_midx(int row) { return row < SEQ ? 0 : (row < NLAT ? 1 : 2); }

namespace pg8 {
constexpr int BM = 256, BK = 64, HALF = 128, HTB = HALF * BK * 2, STAGE_BYTES = 8 * HTB, NXCD = 8, WGM = 8;
__host__ __device__ __forceinline__ int lds_byte(int r, int c) { const int st = (r >> 4) * 2 + (c >> 5), rr = r & 15, cc = c & 31, ob = rr * 64 + cc * 2; return st * 1024 + (ob ^ (((ob >> 9) & 1) << 5)); }
__host__ __device__ __forceinline__ void stage_rc(int b, int& R, int& C) { const int st = b / 1024, sb = b % 1024, swz = sb ^ (((sb >> 9) & 1) << 5); R = (st >> 1) * 16 + swz / 64; C = (st & 1) * 32 + (swz % 64) / 2; }
__host__ __device__ __forceinline__ int perm32(int rho) { const int n = rho >> 4, i = rho & 15; return 8 * (i >> 2) + 4 * n + (i & 3); }

struct Unit { int pm, pn; };
struct Gemm { const bf16_t* A; const bf16_t* Bt; int M, N, K, lda; };

struct StaticOrder {
    int nM, nN, nwg, G, c;
    __device__ void init(int M, int N, int G_, int c_) { nM = M / BM; nN = N / BM; nwg = nM * nN; G = G_; c = c_; }
    __device__ bool next(int i, Unit& u) const {
        const long L = (long)i * G + c; if (L >= nwg) return false;
        int wgid = (int)L; { const int q = nwg / NXCD, r = nwg % NXCD, xcd = wgid % NXCD, off = wgid / NXCD; wgid = (xcd < r ? xcd * (q + 1) : r * (q + 1) + (xcd - r) * q) + off; }
        const int nig = WGM * nN, gid = wgid / nig, fm = gid * WGM, gsz = (nM - fm) < WGM ? (nM - fm) : WGM;
        u.pm = fm + ((wgid % nig) % gsz); u.pn = (wgid % nig) / gsz; return true;
    }
};

template <bool SCALED> struct EpiBf16 {
    static constexpr bool PERM = true;
    bf16_t* O; int ldc; const float* rs; int rsel; float mul;
    __device__ __forceinline__ void operator()(const f32x4 (&acc)[2][2][4][2], const Unit& u, int wr, int wc, int fr, int fq) const {
        const int row0 = u.pm * BM + wr * 64 + fr, col0 = u.pn * BM + wc * 32 + 8 * fq;
#pragma unroll
        for (int ai = 0; ai < 2; ++ai)
#pragma unroll
            for (int m = 0; m < 4; ++m) { const int row = row0 + ai * HALF + m * 16; bf16_t* rowp = O + (size_t)row * ldc + col0;
                float sc = 1.0f; if constexpr (SCALED) sc = rs[(size_t)row * 2 + rsel] * mul;
#pragma unroll
                for (int bj = 0; bj < 2; ++bj) { const f32x4 v0 = acc[ai][bj][m][0] * sc, v1 = acc[ai][bj][m][1] * sc;
                    u32x4 w; w.x = cvt_pk_bf16(v0[0], v0[1]); w.y = cvt_pk_bf16(v0[2], v0[3]); w.z = cvt_pk_bf16(v1[0], v1[1]); w.w = cvt_pk_bf16(v1[2], v1[3]);
                    *(u32x4*)(rowp + bj * HALF) = w; }
                if constexpr (SCALED) asm volatile("" ::: "memory"); }
    }
};
struct EpiResid {
    static constexpr bool PERM = false;
    float* X; const float* gate;
    __device__ __forceinline__ void operator()(const f32x4 (&acc)[2][2][4][2], const Unit& u, int wr, int wc, int fr, int fq) const {
        const int midx = u.pm < 64 ? 0 : (u.pm < 128 ? 1 : 2);
        const float* g = gate + (size_t)midx * MODW;
        const int row0 = u.pm * BM + wr * 64 + fr, col0 = u.pn * BM + wc * 32 + 4 * fq;
        f32x4 gv[2][2];
#pragma unroll
        for (int bj = 0; bj < 2; ++bj)
#pragma unroll
            for (int n = 0; n < 2; ++n) gv[bj][n] = *(const f32x4*)(g + col0 + bj * HALF + n * 16);
#pragma unroll
        for (int ai = 0; ai < 2; ++ai)
#pragma unroll
            for (int m = 0; m < 4; ++m) { float* rowp = X + (size_t)(row0 + ai * HALF + m * 16) * DM + col0;
#pragma unroll
                for (int bj = 0; bj < 2; ++bj)
#pragma unroll
                    for (int n = 0; n < 2; ++n) { float* p = rowp + bj * HALF + n * 16; const f32x4 x = *(const f32x4*)p; *(f32x4*)p = x + gv[bj][n] * acc[ai][bj][m][n]; } }
    }
};
struct EpiGlu {
    static constexpr bool PERM = true;
    bf16_t* ACT; const float* cw; const float* cb; float* side;
    __device__ __forceinline__ void operator()(const f32x4 (&acc)[2][2][4][2], const Unit& u, int wr, int wc, int fr, int fq) const {
        const int ch0 = u.pn * HALF + wc * 32 + 8 * fq;
        const int lane = (int)(threadIdx.x & 63);
        const int src_prev = (lane & 48) | ((fr + 15) & 15), src_next = (lane & 48) | ((fr + 1) & 15);
#pragma unroll
        for (int ai = 0; ai < 2; ++ai) {
            const int blk = u.pm * 4 + ai * 2 + wr;
            unsigned pk[4][4];
#pragma unroll
            for (int n = 0; n < 2; ++n) {
                const f32x4 w0 = *(const f32x4*)(cw + ch0 + 4 * n), w1 = *(const f32x4*)(cw + FFD + ch0 + 4 * n), w2 = *(const f32x4*)(cw + 2 * FFD + ch0 + 4 * n), bb = *(const f32x4*)(cb + ch0 + 4 * n);
                f32x4 R[4], Lr[4];
#pragma unroll
                for (int m = 0; m < 4; ++m)
#pragma unroll
                    for (int j = 0; j < 4; ++j) { const float g = acc[ai][0][m][n][j]; R[m][j] = __shfl(g, src_prev); Lr[m][j] = __shfl(g, src_next); }
#pragma unroll
                for (int m = 0; m < 4; ++m) {
                    f32x4 prev = R[m], next = Lr[m];
                    if (fr == 0) prev = (m > 0) ? R[m > 0 ? m - 1 : 0] : (f32x4){0.f, 0.f, 0.f, 0.f};
                    if (fr == 15) next = (m < 3) ? Lr[m < 3 ? m + 1 : 3] : (f32x4){0.f, 0.f, 0.f, 0.f};
                    const f32x4 g = acc[ai][0][m][n], v = acc[ai][1][m][n];
                    const f32x4 c = bb + w0 * prev + w1 * g + w2 * next;
                    float a[4];
#pragma unroll
                    for (int j = 0; j < 4; ++j) a[j] = silu_f(c[j]) * v[j];
                    pk[m][2 * n] = cvt_pk_bf16(a[0], a[1]); pk[m][2 * n + 1] = cvt_pk_bf16(a[2], a[3]);
                }
            }
#pragma unroll
            for (int m = 0; m < 4; ++m) {
                const int row = u.pm * BM + ai * HALF + wr * 64 + m * 16 + fr;
                u32x4 w; w.x = pk[m][0]; w.y = pk[m][1]; w.z = pk[m][2]; w.w = pk[m][3];
                const bool edge = (m == 0 && fr == 0) || (m == 3 && fr == 15);
                if (!edge) *(u32x4*)(ACT + (size_t)row * FFD + ch0) = w;
            }
            float* sb = side + (size_t)blk * FFD + ch0;
            if (fr == 0)  { *(f32x4*)(sb + 0 * SIDE_ARR) = acc[ai][0][0][0]; *(f32x4*)(sb + 0 * SIDE_ARR + 4) = acc[ai][0][0][1]; *(f32x4*)(sb + 4 * SIDE_ARR) = acc[ai][1][0][0]; *(f32x4*)(sb + 4 * SIDE_ARR + 4) = acc[ai][1][0][1]; }
            if (fr == 1)  { *(f32x4*)(sb + 1 * SIDE_ARR) = acc[ai][0][0][0]; *(f32x4*)(sb + 1 * SIDE_ARR + 4) = acc[ai][0][0][1]; }
            if (fr == 14) { *(f32x4*)(sb + 2 * SIDE_ARR) = acc[ai][0][3][0]; *(f32x4*)(sb + 2 * SIDE_ARR + 4) = acc[ai][0][3][1]; }
            if (fr == 15) { *(f32x4*)(sb + 3 * SIDE_ARR) = acc[ai][0][3][0]; *(f32x4*)(sb + 3 * SIDE_ARR + 4) = acc[ai][0][3][1]; *(f32x4*)(sb + 5 * SIDE_ARR) = acc[ai][1][3][0]; *(f32x4*)(sb + 5 * SIDE_ARR + 4) = acc[ai][1][3][1]; }
        }
    }
};

template <class Epi>
__device__ __forceinline__ void gemm_phase(LAS unsigned char* lds, const Gemm g, const StaticOrder& S, const Epi& E) {
    int tid = threadIdx.x; asm volatile("" : "+v"(tid));
    const int wid = __builtin_amdgcn_readfirstlane(tid >> 6), lane = tid & 63, wr = wid >> 2, wc = wid & 3, fr = lane & 15, fq = lane >> 4;
    const int K = g.K, nt = K / BK, lda = g.lda;
    unsigned voffA[2], voffB[2];
#pragma unroll
    for (int i = 0; i < 2; ++i) { int R, C; stage_rc(tid * 16 + i * 8192, R, C); const int Rb = Epi::PERM ? ((R & ~31) + perm32(R & 31)) : R;
        voffA[i] = (unsigned)(R * lda + C) * 2u; voffB[i] = (unsigned)(Rb * K + C) * 2u; }
    const size_t kstep = (size_t)(BK * 2);
    const size_t hA = (size_t)HALF * lda * 2, hB = (size_t)HALF * K * 2;
    const size_t tA = 2 * hA, tB = 2 * hB;
    const unsigned ldsw = (unsigned)wid * 1024u;
    const int aoff = lds_byte(wr * 64 + fr, fq * 8), boff = lds_byte(wc * 32 + fr, fq * 8);
#define PG8_SA(b, h) (((b) * 2 + (h)) * HTB)
#define PG8_SB(b, h) ((4 + (b) * 2 + (h)) * HTB)
#define PG8_STAGE(bufoff, gbase, voff) do { _Pragma("unroll") for (int _i = 0; _i < 2; ++_i) \
        __builtin_amdgcn_global_load_lds((const unsigned*)((const char*)(gbase) + (voff)[_i]), (LAS unsigned*)(lds + (bufoff) + ldsw + _i * 8192), 16, 0, 0); } while (0)
#define PG8_LDA(dst, b, h) do { _Pragma("unroll") for (int m = 0; m < 4; ++m) _Pragma("unroll") for (int k = 0; k < 2; ++k) dst[m][k] = *(const LAS bf16x8*)(lds + PG8_SA(b, h) + aoff + m * 2048 + k * 1024); } while (0)
#define PG8_LDB(dst, b, h) do { _Pragma("unroll") for (int n = 0; n < 2; ++n) _Pragma("unroll") for (int k = 0; k < 2; ++k) dst[n][k] = *(const LAS bf16x8*)(lds + PG8_SB(b, h) + boff + n * 2048 + k * 1024); } while (0)
#define PG8_MMA(ai, bj, At, Bt) do { __builtin_amdgcn_s_setprio(1); _Pragma("unroll") for (int m = 0; m < 4; ++m) _Pragma("unroll") for (int n = 0; n < 2; ++n) _Pragma("unroll") for (int k = 0; k < 2; ++k) \
        acc[ai][bj][m][n] = __builtin_amdgcn_mfma_f32_16x16x32_bf16(Bt[n][k], At[m][k], acc[ai][bj][m][n], 0, 0, 0); __builtin_amdgcn_s_setprio(0); } while (0)
#define PG8_WAIT_V(n) asm volatile("s_waitcnt vmcnt(" #n ")" ::: "memory")
#define PG8_WAIT_L(n) asm volatile("s_waitcnt lgkmcnt(" #n ")" ::: "memory")
#define PG8_BAR __builtin_amdgcn_s_barrier()
#define PG8_SCHED __builtin_amdgcn_sched_barrier(0)
    Unit cur, nxt; int ui = 0;
    if (!S.next(0, cur)) return;
    f32x4 acc[2][2][4][2];
#pragma unroll
    for (int a = 0; a < 2; ++a)
#pragma unroll
        for (int b = 0; b < 2; ++b)
#pragma unroll
            for (int m = 0; m < 4; ++m)
#pragma unroll
                for (int n = 0; n < 2; ++n) acc[a][b][m][n] = (f32x4){0.f, 0.f, 0.f, 0.f};
    bf16x8 At[4][2], B0[2][2], B1[2][2];
    const char* cA = (const char*)g.A + (size_t)cur.pm * tA; const char* cB = (const char*)g.Bt + (size_t)cur.pn * tB;
    PG8_STAGE(PG8_SB(0, 0), cB, voffB); PG8_STAGE(PG8_SB(0, 1), cB + hB, voffB); PG8_STAGE(PG8_SA(0, 0), cA, voffA); PG8_STAGE(PG8_SA(0, 1), cA + hA, voffA);
    if (wr == 1) PG8_BAR;
    PG8_WAIT_V(2); PG8_BAR;
    PG8_STAGE(PG8_SB(1, 0), cB + kstep, voffB); PG8_STAGE(PG8_SA(1, 0), cA + kstep, voffA); PG8_STAGE(PG8_SB(1, 1), cB + hB + kstep, voffB);
    PG8_WAIT_V(6); PG8_BAR;
    for (;;) {
        const bool has_next = S.next(ui + 1, nxt);
        const char* nA = has_next ? (const char*)g.A + (size_t)nxt.pm * tA : cA; const char* nB = has_next ? (const char*)g.Bt + (size_t)nxt.pn * tB : cB;
        for (int t = 0; t < nt; t += 2) {
            const bool last = (t == nt - 2);
            const char* a1 = cA + (size_t)(t + 1) * kstep;
            const char* a2 = last ? nA : cA + (size_t)(t + 2) * kstep; const char* b2 = last ? nB : cB + (size_t)(t + 2) * kstep;
            const char* a3 = a2 + kstep; const char* b3 = b2 + kstep;
            PG8_LDB(B0, 0, 0); PG8_LDB(B1, 0, 1); PG8_SCHED; PG8_LDA(At, 0, 0); PG8_STAGE(PG8_SA(1, 1), a1 + hA, voffA);
            PG8_WAIT_V(8); PG8_WAIT_L(0); PG8_BAR; PG8_MMA(0, 0, At, B0); PG8_MMA(0, 1, At, B1); PG8_BAR; PG8_SCHED;
            PG8_LDA(At, 0, 1); PG8_STAGE(PG8_SB(0, 0), b2, voffB); PG8_STAGE(PG8_SB(0, 1), b2 + hB, voffB); PG8_STAGE(PG8_SA(0, 0), a2, voffA);
            PG8_WAIT_V(8); PG8_WAIT_L(0); PG8_BAR; PG8_MMA(1, 0, At, B0); PG8_MMA(1, 1, At, B1); PG8_BAR; PG8_SCHED;
            PG8_LDB(B0, 1, 0); PG8_LDB(B1, 1, 1); PG8_SCHED; PG8_LDA(At, 1, 0); PG8_STAGE(PG8_SA(0, 1), a2 + hA, voffA);
            PG8_WAIT_V(8); PG8_WAIT_L(0); PG8_BAR; PG8_MMA(0, 0, At, B0); PG8_MMA(0, 1, At, B1); PG8_BAR; PG8_SCHED;
            PG8_LDA(At, 1, 1); PG8_STAGE(PG8_SB(1, 0), b3, voffB); PG8_STAGE(PG8_SB(1, 1), b3 + hB, voffB); PG8_STAGE(PG8_SA(1, 0), a3, voffA);
            PG8_WAIT_V(8); PG8_WAIT_L(0); PG8_BAR; PG8_MMA(1, 0, At, B0); PG8_MMA(1, 1, At, B1); PG8_BAR; PG8_SCHED;
        }
        if (wr == 0) PG8_BAR;
        E(acc, cur, wr, wc, fr, fq);
        if (!has_next) break;
#pragma unroll
        for (int a = 0; a < 2; ++a)
#pragma unroll
            for (int b = 0; b < 2; ++b)
#pragma unroll
                for (int m = 0; m < 4; ++m)
#pragma unroll
                    for (int n = 0; n < 2; ++n) acc[a][b][m][n] = (f32x4){0.f, 0.f, 0.f, 0.f};
        cur = nxt; cA = nA; cB = nB; ++ui;
        if (wr == 1) PG8_BAR;
    }
    PG8_WAIT_V(0);
    PG8_BAR;
#undef PG8_SA
#undef PG8_SB
#undef PG8_STAGE
#undef PG8_LDA
#undef PG8_LDB
#undef PG8_MMA
#undef PG8_WAIT_V
#undef PG8_WAIT_L
#undef PG8_BAR
#undef PG8_SCHED
}
}

namespace att {
#define SBAR() __builtin_amdgcn_sched_barrier(0)
__device__ __forceinline__ int crow(int r, int hi) { return (r & 3) + 8 * (r >> 2) + 4 * hi; }
template <int DK> __device__ __forceinline__ int kswz(int row, int colB) {
    if (DK == 128) return row * 256 + (colB ^ (((row & 7) << 4) | (((row >> 3) & 1) << 7)));
    else return row * 384 + (colB ^ (((row >> 1) & 7) << 4));
}
template <int DK> struct Sc { static constexpr float SCALE = (DK == 128) ? 0.088388347648318440f : 0.072168783648703220f; };
constexpr float THR = 8.f;

template <int DK>
__device__ __forceinline__ void partialSM(f32x16& p0, f32x16& p1, float& m_reg, float& mn, float& alpha) {
    constexpr float SCALE = Sc<DK>::SCALE, C = SCALE * LOG2E;
    float pmax = p0[0];
#pragma unroll
    for (int r = 1; r < 16; ++r) pmax = fmaxf(pmax, p0[r]);
#pragma unroll
    for (int r = 0; r < 16; ++r) pmax = fmaxf(pmax, p1[r]);
    { auto rr = __builtin_amdgcn_permlane32_swap(__float_as_uint(pmax), __float_as_uint(pmax), false, false);
      pmax = fmaxf(__uint_as_float(rr[0]), __uint_as_float(rr[1])); }
    if (__builtin_expect(__all(pmax - m_reg <= THR / SCALE), 1)) { mn = m_reg; alpha = 1.f; }
    else { mn = fmaxf(m_reg, pmax); alpha = __builtin_amdgcn_exp2f((m_reg - mn) * C); m_reg = mn; }
    const float mnC = -mn * C;
#pragma unroll
    for (int r = 0; r < 16; ++r) p0[r] = fmaf(p0[r], C, mnC);
#pragma unroll
    for (int r = 0; r < 16; ++r) p1[r] = fmaf(p1[r], C, mnC);
#pragma unroll
    for (int r = 0; r < 16; ++r) p0[r] = __builtin_amdgcn_exp2f(p0[r]);
}
__device__ __forceinline__ void finishSM(f32x16& p0, f32x16& p1, float alpha, float& l_reg, bf16x8& pa0, bf16x8& pa1, bf16x8& pa2, bf16x8& pa3) {
#pragma unroll
    for (int r = 0; r < 16; ++r) p1[r] = __builtin_amdgcn_exp2f(p1[r]);
    float ps = 0;
#pragma unroll
    for (int r = 0; r < 16; ++r) ps += p0[r];
#pragma unroll
    for (int r = 0; r < 16; ++r) ps += p1[r];
    { auto rr = __builtin_amdgcn_permlane32_swap(__float_as_uint(ps), __float_as_uint(ps), false, false);
      ps = __uint_as_float(rr[0]) + __uint_as_float(rr[1]); }
    l_reg = l_reg * alpha + ps;
#define PK4(P, BASE, OUT) do { unsigned a0 = cvt_pk_bf16(P[BASE + 0], P[BASE + 1]), a1 = cvt_pk_bf16(P[BASE + 2], P[BASE + 3]);   \
    unsigned b0 = cvt_pk_bf16(P[BASE + 4], P[BASE + 5]), b1 = cvt_pk_bf16(P[BASE + 6], P[BASE + 7]);                              \
    auto r0 = __builtin_amdgcn_permlane32_swap(a0, b0, false, false); auto r1 = __builtin_amdgcn_permlane32_swap(a1, b1, false, false); \
    u32x4 w = {r0[0], r1[0], r0[1], r1[1]}; OUT = *reinterpret_cast<bf16x8*>(&w); } while (0)
    PK4(p0, 0, pa0); PK4(p0, 8, pa1); PK4(p1, 0, pa2); PK4(p1, 8, pa3);
#undef PK4
}
template <int DK, int QL = 0, int PF = 1>
__device__ __forceinline__ void qkt(f32x16& p0, f32x16& p1, const LAS char* Ks, const bf16x8* qr, int r32, int hi, int qlds = 0) {
    p0 = f32x16{}; p1 = f32x16{};
    constexpr int ND = DK / 16;
    if constexpr (QL > 0) asm volatile("" : "+v"(qlds));
    if constexpr (PF <= 1) {
#pragma unroll
        for (int d0 = 0; d0 < ND; ++d0) { const int cb = (d0 * 16 + hi * 8) * 2;
            const bf16x8 b0 = *(const LAS bf16x8*)(Ks + kswz<DK>(r32, cb));
            const bf16x8 b1 = *(const LAS bf16x8*)(Ks + kswz<DK>(32 + r32, cb));
            bf16x8 q;
            if constexpr (QL > 0) { if (d0 >= ND - QL) q = *(const LAS bf16x8*)(uintptr_t)(unsigned)(qlds + (d0 - (ND - QL)) * 1024); else q = qr[d0]; }
            else q = qr[d0];
            p0 = __builtin_amdgcn_mfma_f32_32x32x16_bf16(b0, q, p0, 0, 0, 0);
            p1 = __builtin_amdgcn_mfma_f32_32x32x16_bf16(b1, q, p1, 0, 0, 0); }
    } else {
        bf16x8 kf[PF][2], qf[PF];
#pragma unroll
        for (int s = 0; s < PF; ++s) { const int cb = (s * 16 + hi * 8) * 2;
            kf[s][0] = *(const LAS bf16x8*)(Ks + kswz<DK>(r32, cb)); kf[s][1] = *(const LAS bf16x8*)(Ks + kswz<DK>(32 + r32, cb));
            if constexpr (QL > 0) { if (s >= ND - QL) qf[s] = *(const LAS bf16x8*)(uintptr_t)(unsigned)(qlds + (s - (ND - QL)) * 1024); } }
        SBAR();
#pragma unroll
        for (int d0 = 0; d0 < ND; ++d0) {
            bf16x8 q;
            if constexpr (QL > 0) { if (d0 >= ND - QL) q = qf[d0 % PF]; else q = qr[d0]; } else q = qr[d0];
            p0 = __builtin_amdgcn_mfma_f32_32x32x16_bf16(kf[d0 % PF][0], q, p0, 0, 0, 0);
            p1 = __builtin_amdgcn_mfma_f32_32x32x16_bf16(kf[d0 % PF][1], q, p1, 0, 0, 0);
            if (d0 + PF < ND) { const int s = d0 + PF; const int cb = (s * 16 + hi * 8) * 2;
                kf[d0 % PF][0] = *(const LAS bf16x8*)(Ks + kswz<DK>(r32, cb)); kf[d0 % PF][1] = *(const LAS bf16x8*)(Ks + kswz<DK>(32 + r32, cb));
                if constexpr (QL > 0) { if (s >= ND - QL) qf[d0 % PF] = *(const LAS bf16x8*)(uintptr_t)(unsigned)(qlds + (s - (ND - QL)) * 1024); } }
            SBAR();
        }
    }
}
__device__ __forceinline__ float bf16_rne(float x) { return __uint_as_float(cvt_pk_bf16(x, 0.f) << 16); }
__device__ __forceinline__ void partialSM_ps(f32x16& p0, f32x16& p1, float& m_off, float& alpha, bf16x8& qx, int hi, bool first) {
    float pmax = p0[0];
#pragma unroll
    for (int r = 1; r < 16; ++r) pmax = fmaxf(pmax, p0[r]);
#pragma unroll
    for (int r = 0; r < 16; ++r) pmax = fmaxf(pmax, p1[r]);
    { auto rr = __builtin_amdgcn_permlane32_swap(__float_as_uint(pmax), __float_as_uint(pmax), false, false);
      pmax = fmaxf(__uint_as_float(rr[0]), __uint_as_float(rr[1])); }
    if (__builtin_expect(!first && __all(pmax <= THR * LOG2E), 1)) { alpha = 1.f; }
    else {
        const float d = first ? pmax : fmaxf(pmax, 0.f);
        const float m_new = bf16_rne(m_off + d), delta = m_new - m_off;
        alpha = first ? 1.f : __builtin_amdgcn_exp2f(-delta); m_off = m_new;
#pragma unroll
        for (int r = 0; r < 16; ++r) { p0[r] -= delta; p1[r] -= delta; }
        const unsigned nb = (hi == 0) ? (cvt_pk_bf16(-m_new, 0.f) & 0xffffu) : 0u;
        u32x4 w = {nb, 0u, 0u, 0u}; qx = *reinterpret_cast<bf16x8*>(&w);
    }
#pragma unroll
    for (int r = 0; r < 16; ++r) p0[r] = __builtin_amdgcn_exp2f(p0[r]);
}
__device__ __forceinline__ void qk_offset_step(f32x16& p0, f32x16& p1, bf16x8 onesf, bf16x8 qx) {
    p0 = __builtin_amdgcn_mfma_f32_32x32x16_bf16(onesf, qx, p0, 0, 0, 0);
    p1 = __builtin_amdgcn_mfma_f32_32x32x16_bf16(onesf, qx, p1, 0, 0, 0);
}
__device__ __forceinline__ int v_st(int k, int c) { const int kk = (k & ~0xC) | ((k & 4) << 1) | ((k & 8) >> 1); return ((kk >> 3) * 4 + (c >> 5)) * 512 + ((kk & 7) * 32 + (c & 31)) * 2; }
__device__ __forceinline__ int v_rd_base(int lane) { return ((lane & 3) << 3) | (((lane >> 2) & 3) << 6) | (((lane >> 4) & 1) << 5) | (((lane >> 5) & 1) << 8); }
constexpr int v_rd_off(int d0, int ks, int half) { return d0 * 512 + ks * 4096 + half * 2048; }
template <int OFF> __device__ __forceinline__ s16x4 tr_read(int vb) {
    s16x4 r; asm volatile("ds_read_b64_tr_b16 %0, %1 offset:%2" : "=&v"(r) : "v"(vb), "i"(OFF) : "memory"); return r;
}
template <int D0> __device__ __forceinline__ void pv_one(f32x16& od, int vb, bf16x8 pa0, bf16x8 pa1, bf16x8 pa2, bf16x8 pa3) {
    const s16x4 l0 = tr_read<v_rd_off(D0, 0, 0)>(vb), h0 = tr_read<v_rd_off(D0, 0, 1)>(vb), l1 = tr_read<v_rd_off(D0, 1, 0)>(vb), h1 = tr_read<v_rd_off(D0, 1, 1)>(vb);
    const s16x4 l2 = tr_read<v_rd_off(D0, 2, 0)>(vb), h2 = tr_read<v_rd_off(D0, 2, 1)>(vb), l3 = tr_read<v_rd_off(D0, 3, 0)>(vb), h3 = tr_read<v_rd_off(D0, 3, 1)>(vb);
    asm volatile("s_waitcnt lgkmcnt(0)" ::: "memory"); SBAR();
#define PK(L, H) (bf16x8){L[0], L[1], L[2], L[3], H[0], H[1], H[2], H[3]}
    od = __builtin_amdgcn_mfma_f32_32x32x16_bf16(pa0, PK(l0, h0), od, 0, 0, 0);
    od = __builtin_amdgcn_mfma_f32_32x32x16_bf16(pa1, PK(l1, h1), od, 0, 0, 0);
    od = __builtin_amdgcn_mfma_f32_32x32x16_bf16(pa2, PK(l2, h2), od, 0, 0, 0);
    od = __builtin_amdgcn_mfma_f32_32x32x16_bf16(pa3, PK(l3, h3), od, 0, 0, 0);
#undef PK
}
__device__ __forceinline__ void pv_d0(f32x16* o, int vb, bf16x8 pa0, bf16x8 pa1, bf16x8 pa2, bf16x8 pa3) {
    pv_one<0>(o[0], vb, pa0, pa1, pa2, pa3); pv_one<1>(o[1], vb, pa0, pa1, pa2, pa3); pv_one<2>(o[2], vb, pa0, pa1, pa2, pa3); pv_one<3>(o[3], vb, pa0, pa1, pa2, pa3);
}

template <int DK, int SD, int QL, bool PS, int PF>
__device__ __forceinline__ void dense_body(const bf16_t* __restrict__ Qb, int ldq, const bf16_t* __restrict__ Kh, int ldk, const bf16_t* __restrict__ KPh,
                                           const bf16_t* __restrict__ Vh, int ldv, bf16_t* __restrict__ Ob, int ldo,
                                           int base0, int n0, int base1, int NT, LAS char* lds) {
    constexpr int SHM_V = 64 * 128 * 2, SHM_K = 64 * DK * 2, ND = DK / 16;
    int tid = threadIdx.x; asm volatile("" : "+v"(tid));
    const int wid = tid >> 6, lane = tid & 63, r32 = lane & 31, hi = lane >> 5;
    LAS char* V_lds = lds; LAS char* K_lds = lds + 2 * SHM_V;
    LAS float* ws = (LAS float*)(lds + 2 * SHM_V + 2 * SHM_K) + wid * 64; LAS float* li_l = ws; LAS float* al_l = ws + 32;
    float m_reg = -1e30f, l_reg = 0; f32x16 o[4] = {}; bf16x8 qr[ND - QL];
    const bf16_t* Qw = Qb + (long)(wid * 32 + r32) * ldq + hi * 8;
#pragma unroll
    for (int d0 = 0; d0 < ND - QL; ++d0) qr[d0] = *(const bf16x8*)(Qw + d0 * 16);
    const int qlds = (int)(unsigned)(uintptr_t)(lds + 2 * SHM_V + 2 * SHM_K + 2048) + wid * (QL * 1024) + lane * 16;
    if constexpr (QL > 0) {
#pragma unroll
        for (int d0 = ND - QL; d0 < ND; ++d0) *(LAS bf16x8*)(uintptr_t)(unsigned)(qlds + (d0 - (ND - QL)) * 1024) = *(const bf16x8*)(Qw + d0 * 16);
    }
    const int sr = tid >> 4, sc = (tid & 15) * 8, vst0 = v_st(sr, sc), vst1 = v_st(32 + sr, sc);
    const int pr = tid >> 3, pc = (tid & 7) * 8;
    const int kst0 = kswz<DK>(sr, sc * 2), kst1 = kswz<DK>(32 + sr, sc * 2), kstp = kswz<DK>(pr, 256 + pc * 2);
    const int vb0 = (int)(unsigned)(uintptr_t)V_lds + v_rd_base(lane);
    bf16x8 vs0, vs1, ks0, ks1, kp;
#define TROW(j) ((long)((j) < n0 ? base0 + (j) * 64 : base1 + ((j) - n0) * 64))
#define LOADK(j) do { const long r0_ = TROW(j); ks0 = *(const bf16x8*)(&Kh[(r0_ + sr) * ldk + sc]); ks1 = *(const bf16x8*)(&Kh[(r0_ + 32 + sr) * ldk + sc]); \
    if constexpr (DK == 192) kp = *(const bf16x8*)(&KPh[(r0_ + pr) * 64 + pc]); } while (0)
#define LOADV(j) do { const long r0_ = TROW(j); vs0 = *(const bf16x8*)(&Vh[(r0_ + sr) * ldv + sc]); vs1 = *(const bf16x8*)(&Vh[(r0_ + 32 + sr) * ldv + sc]); } while (0)
#define WRITEK(b) do { *(LAS bf16x8*)(K_lds + (b) * SHM_K + kst0) = ks0; *(LAS bf16x8*)(K_lds + (b) * SHM_K + kst1) = ks1; \
    if constexpr (DK == 192) *(LAS bf16x8*)(K_lds + (b) * SHM_K + kstp) = kp; } while (0)
#define WRITEV(b) do { *(LAS bf16x8*)(V_lds + (b) * SHM_V + vst0) = vs0; *(LAS bf16x8*)(V_lds + (b) * SHM_V + vst1) = vs1; } while (0)
#define VMW0() asm volatile("s_waitcnt vmcnt(0)" ::: "memory")
#define RESC(a) do { if (__any((a) < 1.f)) { if (hi == 0) al_l[r32] = (a); asm volatile("s_waitcnt lgkmcnt(0)" ::: "memory"); \
    _Pragma("unroll") for (int d = 0; d < 4; ++d) _Pragma("unroll") for (int r = 0; r < 16; ++r) o[d][r] *= al_l[crow(r, hi)]; } } while (0)
    f32x16 pA0, pA1, pB0, pB1; float mnA, mnB, alA, alB; bf16x8 pa0, pa1, pa2, pa3;
    bf16x8 qx = {0, 0, 0, 0, 0, 0, 0, 0}, onesf = {0, 0, 0, 0, 0, 0, 0, 0}; float m_off = 0.f;
    if constexpr (PS) { if (hi == 0) onesf[0] = (short)0x3F80; }
    (void)mnA; (void)mnB;
#define SCORES(P0, P1, KB) do { qkt<DK, QL, PF>(P0, P1, KB, qr, r32, hi, qlds); if constexpr (PS) qk_offset_step(P0, P1, onesf, qx); } while (0)
#define PSM(P0, P1, mnC, alC, FIRST) do { if constexpr (PS) partialSM_ps(P0, P1, m_off, alC, qx, hi, FIRST); else partialSM<DK>(P0, P1, m_reg, mnC, alC); } while (0)
#define ITER(j, PAR, PC0, PC1, mnC, alC, PP0, PP1, alP) do { \
    __syncthreads(); \
    SBAR(); SCORES(PC0, PC1, K_lds + (PAR) * SHM_K); SBAR(); \
    VMW0(); \
    if ((j) + 1 < NT) WRITEK(1 - (PAR)); \
    WRITEV(PAR); \
    SBAR(); \
    finishSM(PP0, PP1, alP, l_reg, pa0, pa1, pa2, pa3); SBAR(); \
    if ((j) + 2 < NT) LOADK((j) + 2); \
    if ((j) + 1 < NT) LOADV((j) + 1); \
    SBAR(); \
    pv_d0(o, vb0 + (1 - (PAR)) * SHM_V, pa0, pa1, pa2, pa3); PSM(PC0, PC1, mnC, alC, false); \
    RESC(alC); } while (0)
    LOADK(0); VMW0(); WRITEK(0);
    LOADK(1); LOADV(0); VMW0(); WRITEK(1); WRITEV(0);
    if (2 < NT) LOADK(2);
    LOADV(1);
    __syncthreads();
    SCORES(pA0, pA1, K_lds); PSM(pA0, pA1, mnA, alA, true);
    int j = 1;
    for (; j + 2 <= NT - 1; j += 2) {
        ITER(j, 1, pB0, pB1, mnB, alB, pA0, pA1, alA);
        ITER(j + 1, 0, pA0, pA1, mnA, alA, pB0, pB1, alB);
    }
    ITER(j, 1, pB0, pB1, mnB, alB, pA0, pA1, alA);
    __syncthreads();
    finishSM(pB0, pB1, alB, l_reg, pa0, pa1, pa2, pa3); SBAR();
    pv_d0(o, vb0 + SHM_V, pa0, pa1, pa2, pa3);
    if (hi == 0) li_l[r32] = l_reg; asm volatile("s_waitcnt lgkmcnt(0)" ::: "memory");
    float rli[16];
#pragma unroll
    for (int r = 0; r < 16; ++r) rli[r] = __builtin_amdgcn_rcpf(li_l[crow(r, hi)]);
    bf16_t* Ow = Ob + (long)(wid * 32) * ldo;
#pragma unroll
    for (int r = 0; r < 16; ++r) { const int orow = crow(r, hi);
#pragma unroll
        for (int d0 = 0; d0 < 4; ++d0) Ow[(long)orow * ldo + d0 * 32 + r32] = f2bf(o[d0][r] * rli[r]); }
    asm volatile("s_waitcnt vmcnt(0) lgkmcnt(0)" ::: "memory");
    __syncthreads();
#undef TROW
#undef LOADK
#undef LOADV
#undef WRITEK
#undef WRITEV
#undef VMW0
#undef ITER
#undef SCORES
#undef PSM
}

__device__ __forceinline__ void na_body(const bf16_t* __restrict__ QKV, int b, int rg, int h, const float* __restrict__ rpb_h, bf16_t* __restrict__ O, LAS char* lds, LAS float* tab) {
    constexpr int SHM = 16384, LD = 6144; constexpr float C = 0.088388347648318440f * LOG2E;
    int tid = threadIdx.x; asm volatile("" : "+v"(tid));
    const int wid = tid >> 6, lane = tid & 63, r32 = lane & 31, hi = lane >> 5;
    LAS char* V_lds = lds; LAS char* K_lds = lds + SHM;
    LAS float* ws = (LAS float*)(lds + 2 * SHM) + wid * 64; LAS float* li_l = ws; LAS float* al_l = ws + 32;
    for (int i = tid; i < 465; i += 512) tab[48 + i] = rpb_h[i] * LOG2E;
    const int qrow = 4 * rg + (wid >> 1), qc = (wid & 1) * 32 + r32;
    const int rs = min(max(qrow - 4, 0), 248), cs = min(max(qc - 8, 0), 48);
    const int R0 = min(max(4 * rg - 4, 0), 248), R1 = min(max(4 * rg - 1, 0), 248) + 8, nrt = R1 - R0, NT = nrt + 4;
    float m_reg = -1e30f, l_reg = 0; f32x16 o[4] = {}; bf16x8 qr[8];
    const bf16_t* Qw = QKV + ((long)b * SEQ + qrow * 64 + qc) * LD + h * 128 + hi * 8;
#pragma unroll
    for (int d0 = 0; d0 < 8; ++d0) qr[d0] = *(const bf16x8*)(Qw + d0 * 16);
    const bf16_t* Kh = QKV + 2048 + h * 128; const bf16_t* Vh = QKV + 4096 + h * 128;
    const int sr = tid >> 4, sc = (tid & 15) * 8, vst0 = v_st(sr, sc), vst1 = v_st(32 + sr, sc);
    const int kst0 = kswz<128>(sr, sc * 2), kst1 = kswz<128>(32 + sr, sc * 2);
    const int vb0 = (int)(unsigned)(uintptr_t)V_lds + v_rd_base(lane);
    bf16x8 vs0, vs1, ks0, ks1;
#define TROW(j) ((long)((j) < nrt ? b * SEQ + (R0 + (j)) * 64 : NLAT + b * CTXL + ((j) - nrt) * 64))
#define SLOAD(j) do { const long r0_ = TROW(j); vs0 = *(const bf16x8*)(&Vh[(r0_ + sr) * LD + sc]); vs1 = *(const bf16x8*)(&Vh[(r0_ + 32 + sr) * LD + sc]); \
    ks0 = *(const bf16x8*)(&Kh[(r0_ + sr) * LD + sc]); ks1 = *(const bf16x8*)(&Kh[(r0_ + 32 + sr) * LD + sc]); } while (0)
    SLOAD(0);
    for (int j = 0; j < NT; ++j) {
        asm volatile("s_waitcnt vmcnt(0)" ::: "memory");
        __syncthreads();
        *(LAS bf16x8*)(V_lds + vst0) = vs0; *(LAS bf16x8*)(V_lds + vst1) = vs1; *(LAS bf16x8*)(K_lds + kst0) = ks0; *(LAS bf16x8*)(K_lds + kst1) = ks1;
        __syncthreads();
        if (j + 1 < NT) SLOAD(j + 1);
        const bool isctx = j >= nrt; const int krow = R0 + j;
        if (isctx || (krow >= rs && krow < rs + 8)) {
            f32x16 p0, p1;
            qkt<128>(p0, p1, K_lds, qr, r32, hi);
            if (!isctx) {
                const int dr = krow - qrow + 7;
                const LAS float* tb = tab + 48 + dr * 31 + 15 - qc + 4 * hi;
#pragma unroll
                for (int r = 0; r < 16; ++r) { const int c0 = (r & 3) + 8 * (r >> 2); const int kc0 = c0 + 4 * hi, kc1 = kc0 + 32;
                    const float b0 = tb[c0], b1 = tb[c0 + 32];
                    p0[r] = (kc0 >= cs && kc0 < cs + 16) ? fmaf(p0[r], C, b0) : -1e30f;
                    p1[r] = (kc1 >= cs && kc1 < cs + 16) ? fmaf(p1[r], C, b1) : -1e30f; }
            } else {
#pragma unroll
                for (int r = 0; r < 16; ++r) { p0[r] *= C; p1[r] *= C; }
            }
            float pmax = p0[0];
#pragma unroll
            for (int r = 1; r < 16; ++r) pmax = fmaxf(pmax, p0[r]);
#pragma unroll
            for (int r = 0; r < 16; ++r) pmax = fmaxf(pmax, p1[r]);
            { auto rr = __builtin_amdgcn_permlane32_swap(__float_as_uint(pmax), __float_as_uint(pmax), false, false);
              pmax = fmaxf(__uint_as_float(rr[0]), __uint_as_float(rr[1])); }
            float mn, alpha;
            if (__all(pmax - m_reg <= THR * LOG2E)) { mn = m_reg; alpha = 1.f; }
            else { mn = fmaxf(m_reg, pmax); alpha = __builtin_amdgcn_exp2f(m_reg - mn); m_reg = mn; }
#pragma unroll
            for (int r = 0; r < 16; ++r) { p0[r] = __builtin_amdgcn_exp2f(p0[r] - mn); p1[r] = __builtin_amdgcn_exp2f(p1[r] - mn); }
            bf16x8 pa0, pa1, pa2, pa3;
            float ps = 0;
#pragma unroll
            for (int r = 0; r < 16; ++r) ps += p0[r] + p1[r];
            { auto rr = __builtin_amdgcn_permlane32_swap(__float_as_uint(ps), __float_as_uint(ps), false, false);
              ps = __uint_as_float(rr[0]) + __uint_as_float(rr[1]); }
            l_reg = l_reg * alpha + ps;
#define PK4(P, BASE, OUT) do { unsigned a0 = cvt_pk_bf16(P[BASE + 0], P[BASE + 1]), a1 = cvt_pk_bf16(P[BASE + 2], P[BASE + 3]);   \
    unsigned b0 = cvt_pk_bf16(P[BASE + 4], P[BASE + 5]), b1 = cvt_pk_bf16(P[BASE + 6], P[BASE + 7]);                              \
    auto r0 = __builtin_amdgcn_permlane32_swap(a0, b0, false, false); auto r1 = __builtin_amdgcn_permlane32_swap(a1, b1, false, false); \
    u32x4 w = {r0[0], r1[0], r0[1], r1[1]}; OUT = *reinterpret_cast<bf16x8*>(&w); } while (0)
            PK4(p0, 0, pa0); PK4(p0, 8, pa1); PK4(p1, 0, pa2); PK4(p1, 8, pa3);
#undef PK4
            RESC(alpha);
            pv_d0(o, vb0, pa0, pa1, pa2, pa3);
        }
    }
    if (hi == 0) li_l[r32] = l_reg; asm volatile("s_waitcnt lgkmcnt(0)" ::: "memory");
    float rli[16];
#pragma unroll
    for (int r = 0; r < 16; ++r) rli[r] = __builtin_amdgcn_rcpf(li_l[crow(r, hi)]);
    bf16_t* Ow = O + ((long)b * SEQ + qrow * 64 + (wid & 1) * 32) * DM + h * 128;
#pragma unroll
    for (int r = 0; r < 16; ++r) { const int orow = crow(r, hi);
#pragma unroll
        for (int d0 = 0; d0 < 4; ++d0) Ow[(long)orow * DM + d0 * 32 + r32] = f2bf(o[d0][r] * rli[r]); }
    asm volatile("s_waitcnt vmcnt(0) lgkmcnt(0)" ::: "memory");
    __syncthreads();
#undef TROW
#undef SLOAD
}
#undef RESC
}

#define XB_TMO      128
#define XB_XCNT(j)  (256  + 64 * (j))
#define XB_XSUB(j)  (1280 + 64 * (j))
#define XB_XGEN(j)  (2304 + 64 * (j))
#define XB_TOP      3328
#define XB_TOPGEN   3392
#define XCD_BAR_WORDS 3456
#define XB_SPIN_CAP (1u << 22)
__device__ __forceinline__ unsigned xb_ld(unsigned* p)              { return __hip_atomic_load(p, __ATOMIC_RELAXED, __HIP_MEMORY_SCOPE_AGENT); }
__device__ __forceinline__ unsigned xb_add(unsigned* p, unsigned v) { return __hip_atomic_fetch_add(p, v, __ATOMIC_RELAXED, __HIP_MEMORY_SCOPE_AGENT); }
__device__ __forceinline__ unsigned xb_xcc_id() { return (unsigned)__builtin_amdgcn_s_getreg((3 << 11) | 20) & 0xFu; }
#define XB_SPIN(cond, bar) do { unsigned _sp = 0; while (cond) { __builtin_amdgcn_s_sleep(1); \
    if ((++_sp & 255u) == 0u) { if (xb_ld(&(bar)[XB_TMO])) break; if (_sp > XB_SPIN_CAP) { atomicAdd(&(bar)[XB_TMO], 1u); break; } } } } while (0)
struct XcdBarrier { unsigned* bar; unsigned x; volatile LAS unsigned* st; };
__device__ __forceinline__ XcdBarrier xcd_barrier_post(unsigned* bar, volatile LAS unsigned* st) {
    XcdBarrier b; b.bar = bar; b.x = xb_xcc_id(); b.st = st;
    if (threadIdx.x == 0) (void)xb_add(&bar[XB_XCNT(b.x)], 1u);
    return b;
}
__device__ __forceinline__ void xcd_barrier_complete(unsigned* bar, unsigned x, unsigned& nloc, unsigned& nx) {
    const unsigned G = gridDim.x * gridDim.y * gridDim.z;
    unsigned sum, cnt, mine, sp = 0u;
    for (;;) {
        sum = 0u; cnt = 0u; mine = 0u;
#pragma unroll
        for (unsigned j = 0; j < 16; ++j) { const unsigned c = xb_ld(&bar[XB_XCNT(j)]); sum += c; cnt += (c > 0u) ? 1u : 0u; mine = (j == x) ? c : mine; }
        if (sum == G) break;
        __builtin_amdgcn_s_sleep(1);
        if ((++sp & 255u) == 0u) { if (xb_ld(&bar[XB_TMO])) break; if (sp > XB_SPIN_CAP) { atomicAdd(&bar[XB_TMO], 1u); break; } }
    }
    nloc = mine > 0u ? mine : 1u; nx = cnt > 0u ? cnt : 1u;
}
__device__ __forceinline__ void xcd_barrier(const XcdBarrier& b) {
    asm volatile("s_waitcnt vmcnt(0)" ::: "memory");
    __syncthreads();
    if (threadIdx.x == 0) {
        unsigned* bar = b.bar;
        __builtin_amdgcn_s_waitcnt(0);
        unsigned nloc = b.st[0], nx = b.st[1];
        if (nloc == 0u) { xcd_barrier_complete(bar, b.x, nloc, nx); b.st[0] = nloc; b.st[1] = nx; }
        const unsigned old = xb_add(&bar[XB_XSUB(b.x)], 1u);
        const unsigned gen = old / nloc;
        if (old + 1u == (gen + 1u) * nloc) {
            __builtin_amdgcn_fence(__ATOMIC_RELEASE, "agent");
            asm volatile("s_waitcnt vmcnt(0)" ::: "memory");
            const unsigned og = xb_add(&bar[XB_TOP], 1u);
            const unsigned tg = og / nx;
            if (og + 1u == (tg + 1u) * nx) xb_add(&bar[XB_TOPGEN], 1u);
            else XB_SPIN(xb_ld(&bar[XB_TOPGEN]) == tg, bar);
            __builtin_amdgcn_fence(__ATOMIC_ACQUIRE, "agent");
            xb_add(&bar[XB_XGEN(b.x)], 1u);
            asm volatile("s_waitcnt vmcnt(0)" ::: "memory");
        } else {
            XB_SPIN(xb_ld(&bar[XB_XGEN(b.x)]) == gen, bar);
            __builtin_amdgcn_fence(__ATOMIC_ACQUIRE, "agent");
            asm volatile("s_waitcnt vmcnt(0)" ::: "memory");
        }
    }
    __syncthreads();
}

constexpr int NIN = 27;
struct Args { const float* in[NIN]; float* out; unsigned char* ws; int ph_lo, ph_hi; unsigned rep_mask, pad; };
struct Frame {
    LAS unsigned char* lds; int tid, lane, wave, vcu, G, gw, NGW;
    unsigned char* ws; float* X; bf16_t* H; bf16_t* O; unsigned char* big; unsigned char* wts; float* mods; float* tab; float* rs;
};
constexpr int PPL = 11;
constexpr int NPH = 1 + DEPTH * PPL + 1;
__host__ __device__ inline bool phase_exists(int ph) {
    if (ph == 0 || ph == NPH - 1) return true;
    const int l = (ph - 1) / PPL, j = (ph - 1) % PPL, kind = l % 3;
    if (j == 2) return kind != 0;
    if (j == 3 || j == 4) return kind == 1;
    return true;
}

__device__ __forceinline__ void transpose_item(const float* W, int K, int N, bf16_t* WT, int mode, int row_off, const float* ks, LAS float* scr, int item, int lane) {
    const int nblk = N / 32, kb = item / nblk, nb = item % nblk, k0 = 64 * kb, n0 = 32 * nb;
#pragma unroll 8
    for (int i = 0; i < 32; ++i) { const int kk = 2 * i + (lane >> 5); float v = W[(size_t)(k0 + kk) * N + n0 + (lane & 31)]; if (ks) v *= ks[k0 + kk]; scr[kk * 33 + (lane & 31)] = v; }
    asm volatile("s_waitcnt lgkmcnt(0)" ::: "memory");
    const int c = lane & 7;
#pragma unroll
    for (int j = 0; j < 4; ++j) { const int n = (lane >> 3) + 8 * j; const LAS float* s = scr + (8 * c) * 33 + n;
        u32x4 o; o.x = cvt_pk_bf16(s[0 * 33], s[1 * 33]); o.y = cvt_pk_bf16(s[2 * 33], s[3 * 33]); o.z = cvt_pk_bf16(s[4 * 33], s[5 * 33]); o.w = cvt_pk_bf16(s[6 * 33], s[7 * 33]);
        const int nn = n0 + n; int drow;
        if (mode == 1) { if (nn < FFD) drow = (nn >> 7) * 256 + (nn & 127); else { const int ch = nn - FFD; drow = (ch >> 7) * 256 + 128 + (ch & 127); } }
        else drow = row_off + nn;
        *(u32x4*)(WT + (size_t)drow * K + k0 + 8 * c) = o; }
    asm volatile("s_waitcnt lgkmcnt(0)" ::: "memory");
}

typedef const __attribute__((address_space(4))) Args* KArgs;
__device__ __forceinline__ void prologue_phase(Frame& F, KArgs a) {
    LAS float* sil = (LAS float*)F.lds;
    for (int i = F.tid; i < 3 * DM; i += 512) { const int j = i / DM, k = i % DM; const float c = (j < 2) ? a->in[1][j * DM + k] : a->in[3][k]; sil[i] = silu_f(c); }
    __syncthreads();
    for (int task = F.gw; task < DEPTH * (MODW / 32); task += F.NGW) {
        const int l = task / (MODW / 32), n0 = (task % (MODW / 32)) * 32, col = n0 + (F.lane & 31), kp = F.lane >> 5;
        const float* w = a->in[4] + (size_t)l * DM * MODW + col;
        float a0 = 0.f, a1 = 0.f, a2 = 0.f;
#pragma unroll 8
        for (int k = kp; k < DM; k += 2) { const float wv = w[(size_t)k * MODW]; a0 = fmaf(sil[k], wv, a0); a1 = fmaf(sil[DM + k], wv, a1); a2 = fmaf(sil[2 * DM + k], wv, a2); }
        a0 += __shfl_xor(a0, 32); a1 += __shfl_xor(a1, 32); a2 += __shfl_xor(a2, 32);
        if (kp == 0) { const float bv = a->in[5][l * MODW + col]; float* m = F.mods + (size_t)l * 3 * MODW + col; m[0] = a0 + bv; m[MODW] = a1 + bv; m[2 * MODW] = a2 + bv; }
    }
    if (blockIdx.x == 0) {
        for (int i = F.tid; i < 256 * 16 + 256 * 32; i += 512) {
            int pos, ii, quarter; float* cdst; float* sdst;
            if (i < 256 * 16) { pos = i / 16; ii = i % 16; quarter = 16; cdst = F.tab + i; sdst = F.tab + 4096 + i; }
            else { const int k = i - 256 * 16; pos = k / 32; ii = k % 32; quarter = 32; cdst = F.tab + 8192 + k; sdst = F.tab + 16384 + k; }
            const float inv = exp2f(-13.287712379549449f * (float)ii / (float)quarter);
            const float ang = (float)pos * inv;
            const double rev = (double)ang * 0.15915494309189535; const double fr = rev - floor(rev);
            *cdst = __builtin_amdgcn_cosf((float)fr); *sdst = __builtin_amdgcn_sinf((float)fr);
        }
    }
    LAS float* scr = (LAS float*)(F.lds + 32768 + F.wave * 8704);
    {
        constexpr int I_UP = (DM / 64) * (2 * FFD / 32), I_DN = (FFD / 64) * (DM / 32), I_NQ = (DM / 64) * (3 * DM / 32), I_NO = (DM / 64) * (DM / 32);
        constexpr int I_MQA = (DM / 64) * (512 / 32), I_MKA = (DM / 64) * (576 / 32), I_MQB = (512 / 64) * (3072 / 32), I_MKB = (512 / 64) * (4096 / 32), I_MO = I_NO;
        constexpr int I_GQ = (DM / 64) * (3072 / 32), I_GO = I_NO;
        constexpr int NITEMS = 4 * I_UP + 4 * I_DN + 2 * I_NQ + 2 * I_NO + I_MQA + I_MKA + I_MQB + I_MKB + I_MO + I_GQ + I_GO;
        bf16_t* wt = (bf16_t*)F.wts;
        for (int it = F.gw; it < NITEMS; it += F.NGW) {
            int r = it;
            if (r < 4 * I_UP) { const int l = r / I_UP; transpose_item(a->in[8] + (size_t)l * DM * 2 * FFD, DM, 2 * FFD, (bf16_t*)(F.wts + W_UP + l * W_UP_L), 1, 0, nullptr, scr, r % I_UP, F.lane); continue; } r -= 4 * I_UP;
            if (r < 4 * I_DN) { const int l = r / I_DN; transpose_item(a->in[11] + (size_t)l * FFD * DM, FFD, DM, (bf16_t*)(F.wts + W_DN + l * W_DN_L), 0, 0, nullptr, scr, r % I_DN, F.lane); continue; } r -= 4 * I_DN;
            if (r < 2 * I_NQ) { const int l = r / I_NQ; transpose_item(a->in[12] + (size_t)l * DM * 3 * DM, DM, 3 * DM, (bf16_t*)(F.wts + W_NAQKV + l * W_NAQKV_L), 0, 0, nullptr, scr, r % I_NQ, F.lane); continue; } r -= 2 * I_NQ;
            if (r < 2 * I_NO) { const int l = r / I_NO; transpose_item(a->in[14] + (size_t)l * DM * DM, DM, DM, (bf16_t*)(F.wts + W_NAWO + l * W_NAWO_L), 0, 0, nullptr, scr, r % I_NO, F.lane); continue; } r -= 2 * I_NO;
            if (r < I_MQA) { transpose_item(a->in[15], DM, 512, (bf16_t*)(F.wts + W_MLA1), 0, 0, nullptr, scr, r, F.lane); continue; } r -= I_MQA;
            if (r < I_MKA) { transpose_item(a->in[18], DM, 576, (bf16_t*)(F.wts + W_MLA1), 0, 512, nullptr, scr, r, F.lane); continue; } r -= I_MKA;
            if (r < I_MQB) { transpose_item(a->in[17], 512, 3072, (bf16_t*)(F.wts + W_MLAQB), 0, 0, a->in[16], scr, r, F.lane); continue; } r -= I_MQB;
            if (r < I_MKB) { transpose_item(a->in[20], 512, 4096, (bf16_t*)(F.wts + W_MLAKVB), 0, 0, a->in[19], scr, r, F.lane); continue; } r -= I_MKB;
            if (r < I_MO) { transpose_item(a->in[21], DM, DM, (bf16_t*)(F.wts + W_MLAWO), 0, 0, nullptr, scr, r, F.lane); continue; } r -= I_MO;
            if (r < I_GQ) { transpose_item(a->in[22], DM, 3072, (bf16_t*)(F.wts + W_GQAQKV), 0, 0, nullptr, scr, r, F.lane); continue; } r -= I_GQ;
            transpose_item(a->in[25], DM, DM, (bf16_t*)(F.wts + W_GQAWO), 0, 0, nullptr, scr, r, F.lane);
        }
        (void)wt;
        u32x4* z = (u32x4*)(F.wts + W_MLA1 + (size_t)1088 * DM * 2);
        const u32x4 zero = {0u, 0u, 0u, 0u};
        for (int i = blockIdx.x * 512 + F.tid; i < 192 * DM * 2 / 16; i += F.G * 512) z[i] = zero;
    }
    {
        const f32x4* xs = (const f32x4*)a->in[0]; const f32x4* cs = (const f32x4*)a->in[2]; f32x4* xd = (f32x4*)F.X;
        const size_t n1 = (size_t)NLAT * DM / 4, n2 = (size_t)NBATCH * CTXL * DM / 4;
        for (size_t i = (size_t)blockIdx.x * 512 + F.tid; i < n1 + n2; i += (size_t)F.G * 512) xd[i] = i < n1 ? xs[i] : cs[i - n1];
    }
}

__device__ __forceinline__ void norm_phase(Frame& F, const float* gain, const float* mods_l, int sh_off, int sc_off, int nrows) {
    for (int row = F.gw; row < nrows; row += F.NGW) {
        const float* m = mods_l + (size_t)row_midx(row) * MODW;
        const f32x4* xr = (const f32x4*)(F.X + (size_t)row * DM) + F.lane;
        f32x4 v[8]; float s = 0.f;
#pragma unroll
        for (int j = 0; j < 8; ++j) { v[j] = xr[64 * j]; s += (v[j].x * v[j].x + v[j].y * v[j].y) + (v[j].z * v[j].z + v[j].w * v[j].w); }
        const float rstd = rsqrtf(wave_sum(s) * (1.f / DM) + NORM_EPS);
        u32x2* o8 = (u32x2*)(F.H + (size_t)row * DM) + F.lane;
#pragma unroll
        for (int j = 0; j < 8; ++j) { const int col = (F.lane + 64 * j) * 4;
            const f32x4 g = *(const f32x4*)(gain + col), sc = *(const f32x4*)(m + sc_off + col), sh = *(const f32x4*)(m + sh_off + col);
            const f32x4 y = (v[j] * rstd) * g * (sc + 1.0f) + sh;
            u32x2 w; w.x = cvt_pk_bf16(y.x, y.y); w.y = cvt_pk_bf16(y.z, y.w); o8[64 * j] = w; }
    }
}
__device__ __forceinline__ void final_phase(Frame& F, const float* gain, float* out) {
    for (int row = F.gw; row < NLAT; row += F.NGW) {
        const f32x4* xr = (const f32x4*)(F.X + (size_t)row * DM) + F.lane;
        f32x4 v[8]; float s = 0.f;
#pragma unroll
        for (int j = 0; j < 8; ++j) { v[j] = xr[64 * j]; s += (v[j].x * v[j].x + v[j].y * v[j].y) + (v[j].z * v[j].z + v[j].w * v[j].w); }
        const float rstd = rsqrtf(wave_sum(s) * (1.f / DM) + NORM_EPS);
        f32x4* o = (f32x4*)(out + (size_t)row * DM) + F.lane;
#pragma unroll
        for (int j = 0; j < 8; ++j) { const int col = (F.lane + 64 * j) * 4; o[64 * j] = (v[j] * rstd) * *(const f32x4*)(gain + col); }
    }
}
__device__ __forceinline__ void mla_post1_phase(Frame& F) {
    const bf16_t* T1 = (const bf16_t*)(F.big + BIG_T1); bf16_t* KPE = (bf16_t*)(F.big + BIG_KPE);
    const float* tc = F.tab; const float* ts = F.tab + 4096;
    for (int row = F.gw; row < MROWS; row += F.NGW) {
        const bf16_t* t = T1 + (size_t)row * 1280;
        const u32x4 qa = *(const u32x4*)(t + F.lane * 8), ka = *(const u32x4*)(t + 512 + F.lane * 8);
        float sa = 0.f, sb = 0.f;
#pragma unroll
        for (int j = 0; j < 4; ++j) { const float a0 = bf_lo(qa[j]), a1 = bf_hi(qa[j]), b0 = bf_lo(ka[j]), b1 = bf_hi(ka[j]); sa += a0 * a0 + a1 * a1; sb += b0 * b0 + b1 * b1; }
        sa = wave_sum(sa); sb = wave_sum(sb);
        if (F.lane == 0) { F.rs[(size_t)row * 2] = rsqrtf(sa * (1.f / 512.f) + NORM_EPS); F.rs[(size_t)row * 2 + 1] = rsqrtf(sb * (1.f / 512.f) + NORM_EPS); }
        float x = bf2f(t[1024 + F.lane]);
        const float xp = __shfl_xor(x, 16);
        if (row < NLAT) { const int tok = row & (SEQ - 1); const int pos = (F.lane < 32) ? (tok >> 6) : (tok & 63); const int ii = F.lane & 15;
            const float c = tc[pos * 16 + ii], s = ts[pos * 16 + ii]; x = (F.lane & 16) ? (x * c + xp * s) : (x * c - xp * s); }
        KPE[(size_t)row * 64 + F.lane] = f2bf(x);
    }
}
__device__ __forceinline__ void mla_qrope_phase(Frame& F) {
    bf16_t* Q = (bf16_t*)(F.big + BIG_Q); const float* tc = F.tab; const float* ts = F.tab + 4096;
    for (int row = F.gw; row < NLAT; row += F.NGW) {
        const int tok = row & (SEQ - 1), e4 = (F.lane & 15) * 4, q = e4 >> 4, pos = (q < 2) ? (tok >> 6) : (tok & 63), ii = e4 & 15;
        const f32x4 c = *(const f32x4*)(tc + pos * 16 + ii), s = *(const f32x4*)(ts + pos * 16 + ii);
        const float sg = (q & 1) ? 1.f : -1.f;
        u32x2 w[4];
#pragma unroll
        for (int it = 0; it < 4; ++it) w[it] = *(const u32x2*)(Q + (size_t)row * 3072 + (4 * it + (F.lane >> 4)) * 192 + 128 + e4);
#pragma unroll
        for (int it = 0; it < 4; ++it) {
            u32x2 p; p.x = __shfl_xor(w[it].x, 4); p.y = __shfl_xor(w[it].y, 4);
            const float x0 = bf_lo(w[it].x), x1 = bf_hi(w[it].x), x2 = bf_lo(w[it].y), x3 = bf_hi(w[it].y);
            const float y0 = bf_lo(p.x), y1 = bf_hi(p.x), y2 = bf_lo(p.y), y3 = bf_hi(p.y);
            u32x2 o; o.x = cvt_pk_bf16(x0 * c.x + sg * y0 * s.x, x1 * c.y + sg * y1 * s.y); o.y = cvt_pk_bf16(x2 * c.z + sg * y2 * s.z, x3 * c.w + sg * y3 * s.w);
            *(u32x2*)(Q + (size_t)row * 3072 + (4 * it + (F.lane >> 4)) * 192 + 128 + e4) = o;
        }
    }
}
__device__ __forceinline__ void gqa_post_phase(Frame& F, const float* qn, const float* kn) {
    bf16_t* QKV = (bf16_t*)(F.big + BIG_QKV); const float* tc = F.tab + 8192; const float* ts = F.tab + 16384;
    for (int row = F.gw; row < MROWS; row += F.NGW) {
        const bool lat = row < NLAT; const int tok = row & (SEQ - 1), e4 = (F.lane & 31) * 4, q = e4 >> 5, pos = (q < 2) ? (tok >> 6) : (tok & 63), ii = e4 & 31;
        f32x4 c = {1.f, 1.f, 1.f, 1.f}, s = {0.f, 0.f, 0.f, 0.f};
        if (lat) { c = *(const f32x4*)(tc + pos * 32 + ii); s = *(const f32x4*)(ts + pos * 32 + ii); }
        const float sg = (q & 1) ? 1.f : -1.f;
        const f32x4 gq = *(const f32x4*)(qn + e4), gk = *(const f32x4*)(kn + e4);
#pragma unroll 2
        for (int it = 0; it < 10; ++it) {
            const int hh = 2 * it + (F.lane >> 5);
            bf16_t* p = QKV + (size_t)row * 3072 + hh * 128 + e4;
            const u32x2 w = *(const u32x2*)p;
            float x0 = bf_lo(w.x), x1 = bf_hi(w.x), x2 = bf_lo(w.y), x3 = bf_hi(w.y);
            float ss = x0 * x0 + x1 * x1 + x2 * x2 + x3 * x3;
#pragma unroll
            for (int o = 1; o < 32; o <<= 1) ss += __shfl_xor(ss, o);
            const float rstd = rsqrtf(ss * (1.f / 128.f) + NORM_EPS);
            const f32x4 g = (hh < 16) ? gq : gk;
            x0 = x0 * rstd * g.x; x1 = x1 * rstd * g.y; x2 = x2 * rstd * g.z; x3 = x3 * rstd * g.w;
            const float y0 = __shfl_xor(x0, 8), y1 = __shfl_xor(x1, 8), y2 = __shfl_xor(x2, 8), y3 = __shfl_xor(x3, 8);
            const float qs = (hh < 16) ? (0.088388347648318440f * LOG2E) : 1.0f;
            u32x2 o; o.x = cvt_pk_bf16((x0 * c.x + sg * y0 * s.x) * qs, (x1 * c.y + sg * y1 * s.y) * qs); o.y = cvt_pk_bf16((x2 * c.z + sg * y2 * s.z) * qs, (x3 * c.w + sg * y3 * s.w) * qs);
            *(u32x2*)p = o;
        }
    }
}
__device__ __forceinline__ void ffn_fix_phase(Frame& F, const float* cw, const float* cb, int nblk) {
    bf16_t* ACT = (bf16_t*)(F.big + BIG_ACT); const float* side = (const float*)(F.big + BIG_SIDE);
    const int total = nblk * 2 * (FFD / 4);
    for (int idx = blockIdx.x * 512 + F.tid; idx < total; idx += F.G * 512) {
        const int c4 = idx % (FFD / 4), t = idx / (FFD / 4), which = t & 1, blk = t >> 1, ch = c4 * 4;
        const f32x4 w0 = *(const f32x4*)(cw + ch), w1 = *(const f32x4*)(cw + FFD + ch), w2 = *(const f32x4*)(cw + 2 * FFD + ch), bb = *(const f32x4*)(cb + ch);
        const float* sb = side + (size_t)blk * FFD + ch;
        f32x4 prev, g0, nx, v; int row;
        if (which == 0) { row = blk * 64; const bool st = (row == 0 || row == SEQ || row == NLAT || row == NLAT + CTXL);
            prev = st ? (f32x4){0.f, 0.f, 0.f, 0.f} : *(const f32x4*)(sb - FFD + 3 * SIDE_ARR); g0 = *(const f32x4*)(sb + 0 * SIDE_ARR); nx = *(const f32x4*)(sb + 1 * SIDE_ARR); v = *(const f32x4*)(sb + 4 * SIDE_ARR); }
        else { row = blk * 64 + 63; const bool en = (row == SEQ - 1 || row == NLAT - 1 || row == NLAT + CTXL - 1 || row == MROWS - 1);
            prev = *(const f32x4*)(sb + 2 * SIDE_ARR); g0 = *(const f32x4*)(sb + 3 * SIDE_ARR); nx = en ? (f32x4){0.f, 0.f, 0.f, 0.f} : *(const f32x4*)(sb + FFD + 0 * SIDE_ARR); v = *(const f32x4*)(sb + 5 * SIDE_ARR); }
        const f32x4 c = bb + w0 * prev + w1 * g0 + w2 * nx;
        u32x2 o; o.x = cvt_pk_bf16(silu_f(c.x) * v.x, silu_f(c.y) * v.y); o.y = cvt_pk_bf16(silu_f(c.z) * v.z, silu_f(c.w) * v.w);
        *(u32x2*)(ACT + (size_t)row * FFD + ch) = o;
    }
}

template <int DK, int SD, int QL, bool PS, int PF>
__device__ __forceinline__ void dense_attn_phase(Frame& F, const bf16_t* Q, int ldq, int qhs, const bf16_t* K, int ldk, int khs, int kdiv, const bf16_t* KP, const bf16_t* V, int ldv, bool need_ctx) {
    const int nunits = 2048 + (need_ctx ? 32 : 0);
    for (int u = F.vcu; u < nunits; u += F.G) {
        int b, h, qrow0, base0, n0, base1, NT;
        if (u < 2048) { b = u >> 10; h = (u >> 6) & 15; const int qb = u & 63; qrow0 = b * SEQ + qb * 256; base0 = b * SEQ; n0 = 256; base1 = NLAT + b * CTXL; NT = 260; }
        else { const int uc = u - 2048; b = uc >> 4; h = uc & 15; qrow0 = NLAT + b * CTXL; base0 = 0; n0 = 0; base1 = NLAT + b * CTXL; NT = 4; }
        const int kh = h / kdiv;
        att::dense_body<DK, SD, QL, PS, PF>(Q + (size_t)qrow0 * ldq + h * qhs, ldq, K + kh * khs, ldk, KP, V + kh * khs, ldv, F.O + (size_t)qrow0 * DM + h * 128, DM, base0, n0, base1, NT, (LAS char*)F.lds);
    }
}
__device__ __forceinline__ void na_attn_phase(Frame& F, const float* rpb, bool need_ctx) {
    const bf16_t* QKV = (const bf16_t*)(F.big + BIG_QKV);
    LAS float* tab = (LAS float*)(F.lds + NATAB_OFF);
    for (int u = F.vcu; u < 2048; u += F.G) {
        const int b = u >> 10, h = (u >> 6) & 15, rg = u & 63;
        att::na_body(QKV, b, rg, h, rpb + h * 465, F.O, (LAS char*)F.lds, tab);
    }
    if (need_ctx) {
        for (int uc = F.vcu; uc < 32; uc += F.G) {
            const int b = uc >> 4, h = uc & 15, qrow0 = NLAT + b * CTXL;
            att::dense_body<128, 1, 0, false, 1>(QKV + (size_t)qrow0 * 6144 + h * 128, 6144, QKV + 2048 + h * 128, 6144, nullptr, QKV + 4096 + h * 128, 6144, F.O + (size_t)qrow0 * DM + h * 128, DM, 0, 0, qrow0, 4, (LAS char*)F.lds);
        }
    }
}

__global__ void __launch_bounds__(512, 2) mega_fwd(Args args) {
    extern __shared__ __attribute__((aligned(16))) unsigned char lds[];
    Frame F;
    F.lds = (LAS unsigned char*)lds;
    F.tid = threadIdx.x; F.lane = F.tid & 63; F.wave = __builtin_amdgcn_readfirstlane(F.tid >> 6);
    F.G = gridDim.x; { const int bx = blockIdx.x; F.vcu = (F.G % 8 == 0) ? (bx % 8) * (F.G / 8) + bx / 8 : bx; }
    F.gw = F.vcu * 8 + F.wave; F.NGW = F.G * 8;
    const KArgs kargs = (KArgs)__builtin_amdgcn_kernarg_segment_ptr();
#define PH_BEGIN KArgs ap = kargs; asm volatile("" : "+s"(ap)); { int t_ = threadIdx.x; asm volatile("" : "+v"(t_)); F.tid = t_; F.lane = t_ & 63; } { unsigned char* ws_ = ap->ws; F.ws = ws_; F.X = (float*)(ws_ + WS_X); F.H = (bf16_t*)(ws_ + WS_H); F.O = (bf16_t*)(ws_ + WS_O); \
        F.big = ws_ + WS_BIG; F.wts = ws_ + WS_W; F.mods = (float*)(ws_ + WS_MODS); F.tab = (float*)(ws_ + WS_TAB); F.rs = (float*)(ws_ + WS_RS); } \
        const float* mods_l = F.mods + (size_t)layer * 3 * MODW; (void)mods_l
    volatile LAS unsigned* MISC = (volatile LAS unsigned*)(F.lds + MISC_OFF);
    for (int u = F.tid; u < (LDS_BYTES - LDSCTL_OFF) / 4; u += 512) ((LAS unsigned*)(F.lds + LDSCTL_OFF))[u] = 0u;
    __syncthreads();
    const int lo = kargs->ph_lo, hi = kargs->ph_hi;
    unsigned* barw = (unsigned*)(kargs->ws + WS_CTL) + CW_BAR;
    XcdBarrier bar; bar.bar = barw; bar.x = 0; bar.st = nullptr;
    if (hi - lo > 1) bar = xcd_barrier_post(barw, MISC + 8);
#define IN(k) (lo <= (k) && (k) < hi)
#define SEAM(k) do { if ((k) + 1 < hi) xcd_barrier(bar); } while (0)

    if (EN(0) && IN(0)) { const int layer = 0; PH_BEGIN; _Pragma("nounroll") for (int rp_ = 0; rp_ < RPT(0); ++rp_) prologue_phase(F, ap); SEAM(0); }

    for (int layer = 0; layer < DEPTH; ++layer) {
        const int kind = layer % 3, jm = layer / 3, pb = 1 + layer * PPL;
        const bool last = (layer == DEPTH - 1);
        const int mrows = last ? NLAT : MROWS;
        if (EN(1) && IN(pb + 0)) { PH_BEGIN; _Pragma("nounroll") for (int rp_ = 0; rp_ < RPT(1); ++rp_) norm_phase(F, ap->in[6] + layer * DM, mods_l, 0, DM, MROWS); SEAM(pb + 0); }
        if (IN(pb + 1)) {
            PH_BEGIN; pg8::StaticOrder S;
            if (EN(2) && kind == 0) { pg8::Gemm g{F.H, (const bf16_t*)(F.wts + W_NAQKV + jm * W_NAQKV_L), MROWS, 6144, DM, DM}; S.init(MROWS, 6144, F.G, (int)blockIdx.x);
                pg8::EpiBf16<false> E{(bf16_t*)(F.big + BIG_QKV), 6144, nullptr, 0, 1.0f}; pg8::gemm_phase(F.lds, g, S, E); }
            else if (EN(3) && kind == 1) { pg8::Gemm g{F.H, (const bf16_t*)(F.wts + W_MLA1), MROWS, 1280, DM, DM}; S.init(MROWS, 1280, F.G, (int)blockIdx.x);
                pg8::EpiBf16<false> E{(bf16_t*)(F.big + BIG_T1), 1280, nullptr, 0, 1.0f}; pg8::gemm_phase(F.lds, g, S, E); }
            else if (EN(4) && kind == 2) { pg8::Gemm g{F.H, (const bf16_t*)(F.wts + W_GQAQKV), MROWS, 3072, DM, DM}; S.init(MROWS, 3072, F.G, (int)blockIdx.x);
                pg8::EpiBf16<false> E{(bf16_t*)(F.big + BIG_QKV), 3072, nullptr, 0, 1.0f}; pg8::gemm_phase(F.lds, g, S, E); }
            SEAM(pb + 1);
        }
        if (kind != 0 && IN(pb + 2)) {
            PH_BEGIN;
            _Pragma("nounroll") for (int rp_ = 0; rp_ < RPT(5); ++rp_) { if (EN(5) && kind == 1) mla_post1_phase(F); else if (EN(6) && kind == 2) { if (rp_ == 0) gqa_post_phase(F, ap->in[23], ap->in[24]); } }
            SEAM(pb + 2);
        }
        if (EN(7) && kind == 1 && IN(pb + 3)) {
            PH_BEGIN;
            { pg8::StaticOrder S; pg8::Gemm g{(const bf16_t*)(F.big + BIG_T1), (const bf16_t*)(F.wts + W_MLAQB), MROWS, 3072, 512, 1280}; S.init(MROWS, 3072, F.G, (int)blockIdx.x);
              pg8::EpiBf16<true> E{(bf16_t*)(F.big + BIG_Q), 3072, F.rs, 0, 0.072168783648703220f * LOG2E}; pg8::gemm_phase(F.lds, g, S, E); }
            { pg8::StaticOrder S; pg8::Gemm g{(const bf16_t*)(F.big + BIG_T1) + 512, (const bf16_t*)(F.wts + W_MLAKVB), MROWS, 4096, 512, 1280}; S.init(MROWS, 4096, F.G, (int)blockIdx.x);
              pg8::EpiBf16<true> E{(bf16_t*)(F.big + BIG_KV), 4096, F.rs, 1, 1.0f}; pg8::gemm_phase(F.lds, g, S, E); }
            SEAM(pb + 3);
        }
        if (EN(8) && kind == 1 && IN(pb + 4)) { PH_BEGIN; mla_qrope_phase(F); SEAM(pb + 4); }
        if (IN(pb + 5)) {
            PH_BEGIN;
            if (EN(9) && kind == 0) _Pragma("nounroll") for (int rp_ = 0; rp_ < RPT(9); ++rp_) na_attn_phase(F, ap->in[13] + (size_t)jm * 16 * 465, !last);
            else if (EN(10) && kind == 1) { const bf16_t* KV = (const bf16_t*)(F.big + BIG_KV); _Pragma("nounroll") for (int rp_ = 0; rp_ < RPT(10); ++rp_)
                dense_attn_phase<192, 1, 8, true, 1>(F, (const bf16_t*)(F.big + BIG_Q), 3072, 192, KV, 4096, 256, 1, (const bf16_t*)(F.big + BIG_KPE), KV + 128, 4096, !last); }
            else if (EN(11) && kind == 2) { const bf16_t* QKV = (const bf16_t*)(F.big + BIG_QKV); _Pragma("nounroll") for (int rp_ = 0; rp_ < RPT(11); ++rp_)
                dense_attn_phase<128, 1, 0, true, 2>(F, QKV, 3072, 128, QKV + 2048, 3072, 128, 4, nullptr, QKV + 2560, 3072, !last); }
            SEAM(pb + 5);
        }
        if (EN(12) && IN(pb + 6)) {
            PH_BEGIN;
            const bf16_t* wo = (const bf16_t*)(F.wts + (kind == 0 ? W_NAWO + jm * W_NAWO_L : (kind == 1 ? W_MLAWO : W_GQAWO)));
            pg8::StaticOrder S; pg8::Gemm g{F.O, wo, mrows, DM, DM, DM}; S.init(mrows, DM, F.G, (int)blockIdx.x);
            pg8::EpiResid E{F.X, mods_l + 2 * DM}; pg8::gemm_phase(F.lds, g, S, E);
            SEAM(pb + 6);
        }
        if (EN(1) && IN(pb + 7)) { PH_BEGIN; _Pragma("nounroll") for (int rp_ = 0; rp_ < RPT(1); ++rp_) norm_phase(F, ap->in[7] + layer * DM, mods_l, 3 * DM, 4 * DM, mrows); SEAM(pb + 7); }
        if (EN(13) && IN(pb + 8)) {
            PH_BEGIN;
            pg8::StaticOrder S; pg8::Gemm g{F.H, (const bf16_t*)(F.wts + W_UP + layer * W_UP_L), mrows, 2 * FFD, DM, DM}; S.init(mrows, 2 * FFD, F.G, (int)blockIdx.x);
            pg8::EpiGlu E{(bf16_t*)(F.big + BIG_ACT), ap->in[9] + (size_t)layer * 3 * FFD, ap->in[10] + (size_t)layer * FFD, (float*)(F.big + BIG_SIDE)}; _Pragma("nounroll") for (int rp_ = 0; rp_ < RPT(13); ++rp_) pg8::gemm_phase(F.lds, g, S, E);
            SEAM(pb + 8);
        }
        if (EN(14) && IN(pb + 9)) { PH_BEGIN; _Pragma("nounroll") for (int rp_ = 0; rp_ < RPT(14); ++rp_) ffn_fix_phase(F, ap->in[9] + (size_t)layer * 3 * FFD, ap->in[10] + (size_t)layer * FFD, mrows / 64); SEAM(pb + 9); }
        if (EN(15) && IN(pb + 10)) {
            PH_BEGIN;
            pg8::StaticOrder S; pg8::Gemm g{(const bf16_t*)(F.big + BIG_ACT), (const bf16_t*)(F.wts + W_DN + layer * W_DN_L), mrows, DM, FFD, FFD}; S.init(mrows, DM, F.G, (int)blockIdx.x);
            pg8::EpiResid E{F.X, mods_l + 5 * DM}; pg8::gemm_phase(F.lds, g, S, E);
            SEAM(pb + 10);
        }
    }
    if (EN(16) && IN(NPH - 1)) { const int layer = 0; PH_BEGIN; final_phase(F, ap->in[26], ap->out); }
#undef IN
#undef SEAM
}


#ifndef PROBE_LAYER
#define PROBE_LAYER -1
#endif
#if PROBE_LAYER >= 0
constexpr int PB_NS = 64;
__device__ __forceinline__ int pb_keyrow(int b, int j) { return j < SEQ ? b * SEQ + j : NLAT + b * CTXL + (j - SEQ); }
__device__ __forceinline__ int pb_sample_row(int s, int b, bool with_ctx) {
    if (with_ctx && s >= PB_NS - 4) return NLAT + b * CTXL + ((s * 67) & 255);
    const int sp[8] = {0, 63, 64 * 255, 16383, 64 * 3 + 5, 64 * 252 + 60, 8 * 64 + 8, 100 * 64 + 32};
    int t; if (s < 8) { t = 0;
#pragma unroll
        for (int i = 0; i < 8; ++i) if (s == i) t = sp[i]; }
    else t = (int)(((unsigned)s * 2654435761u) >> 9) & (SEQ - 1);
    return b * SEQ + t;
}
__global__ void pb_proj(const bf16_t* H, int nrows, int smode, int b, int with_ctx, const float* W, int ldw, int col0, int ncols, float* out, int ldo) {
    const long idx = (long)blockIdx.x * 256 + threadIdx.x; const int j = (int)(idx / ncols), c = (int)(idx % ncols); if (j >= nrows) return;
    const int row = smode ? pb_sample_row(j, b, with_ctx) : pb_keyrow(b, j);
    const bf16_t* h = H + (size_t)row * DM; const float* w = W + col0 + c; float acc = 0.f;
    for (int k = 0; k < DM; ++k) acc = fmaf(bf2f(h[k]), w[(size_t)k * ldw], acc);
    out[(size_t)j * ldo + c] = acc;
}
__global__ void pb_proj_f32(const float* A, int lda, int K, int nrows, const float* W, int ldw, int col0, int ncols, float* out, int ldo) {
    const long idx = (long)blockIdx.x * 256 + threadIdx.x; const int j = (int)(idx / ncols), c = (int)(idx % ncols); if (j >= nrows) return;
    const float* a = A + (size_t)j * lda; const float* w = W + col0 + c; float acc = 0.f;
    for (int k = 0; k < K; ++k) acc = fmaf(a[k], w[(size_t)k * ldw], acc);
    out[(size_t)j * ldo + c] = acc;
}
__global__ void pb_normrope(float* buf, int ld, int nrows, int smode, int b, int with_ctx, int noff, int nw, const float* gain, int roff, int rdim) {
    const int j = blockIdx.x * 256 + threadIdx.x; if (j >= nrows) return;
    const int row = smode ? pb_sample_row(j, b, with_ctx) : pb_keyrow(b, j);
    float* p = buf + (size_t)j * ld;
    if (nw > 0) { float ss = 0.f; for (int i = 0; i < nw; ++i) ss += p[noff + i] * p[noff + i]; const float rstd = 1.0f / sqrtf(ss / nw + NORM_EPS); for (int i = 0; i < nw; ++i) p[noff + i] = p[noff + i] * rstd * gain[i]; }
    if (rdim > 0 && row < NLAT) { const int tok = row & (SEQ - 1), q = rdim / 4; const float gr = (float)(tok / GRIDW), gc = (float)(tok % GRIDW);
        for (int i = 0; i < q; ++i) { const float inv = powf(10000.0f, -(float)i / (float)q); const float ar = gr * inv, ac = gc * inv;
            const float x0 = p[roff + i], x1 = p[roff + q + i], x2 = p[roff + 2 * q + i], x3 = p[roff + 3 * q + i];
            const float cr = cosf(ar), sr = sinf(ar), cc = cosf(ac), sc = sinf(ac);
            p[roff + i] = x0 * cr - x1 * sr; p[roff + q + i] = x1 * cr + x0 * sr; p[roff + 2 * q + i] = x2 * cc - x3 * sc; p[roff + 3 * q + i] = x3 * cc + x2 * sc; } }
}
__global__ void pb_attn(const float* Q, int ldq, int dk1, int dk2, const float* K1, int ldk1, const float* K2, int ldk2, const float* V, int ldv, float scale, int mode_lat,
                        const float* rpb_h, const bf16_t* O, int b, int h, int with_ctx, float* scores, unsigned* errbits) {
    __shared__ float qs[192]; __shared__ float red[256]; __shared__ float oref[128];
    const int s = blockIdx.x, tid = threadIdx.x, row = pb_sample_row(s, b, with_ctx); const bool isctx = row >= NLAT; const int tok = row & (SEQ - 1);
    const int mode = isctx ? 1 : mode_lat, nk = mode == 0 ? SEQ + CTXL : (mode == 1 ? CTXL : 128 + CTXL);
    const int r = tok / GRIDW, c = tok % GRIDW, rst = min(max(r - 4, 0), 248), cst = min(max(c - 8, 0), 48);
    if (tid < dk1 + dk2) qs[tid] = Q[(size_t)s * ldq + tid];
    __syncthreads();
    float* sc = scores + (size_t)s * (SEQ + CTXL);
    float lmax = -1e30f;
    for (int i = tid; i < nk; i += 256) { int j; float bias = 0.f;
        if (mode == 0) j = i; else if (mode == 1) j = SEQ + i;
        else if (i < 128) { const int kr = rst + i / 16, kc = cst + i % 16; j = kr * GRIDW + kc; bias = rpb_h[(kr - r + 7) * 31 + (kc - c + 15)]; } else j = SEQ + (i - 128);
        float d = 0.f; for (int t = 0; t < dk1; ++t) d = fmaf(qs[t], K1[(size_t)j * ldk1 + t], d); for (int t = 0; t < dk2; ++t) d = fmaf(qs[dk1 + t], K2[(size_t)j * ldk2 + t], d);
        const float v = d * scale + bias; sc[i] = v; lmax = fmaxf(lmax, v); }
    red[tid] = lmax; __syncthreads(); for (int o = 128; o > 0; o >>= 1) { if (tid < o) red[tid] = fmaxf(red[tid], red[tid + o]); __syncthreads(); }
    const float m = red[0]; __syncthreads();
    float lsum = 0.f; for (int i = tid; i < nk; i += 256) { const float p = expf(sc[i] - m); sc[i] = p; lsum += p; }
    red[tid] = lsum; __syncthreads(); for (int o = 128; o > 0; o >>= 1) { if (tid < o) red[tid] += red[tid + o]; __syncthreads(); }
    const float l = red[0]; __syncthreads();
    if (tid < 128) { float o = 0.f; for (int i = 0; i < nk; ++i) { int j; if (mode == 0) j = i; else if (mode == 1) j = SEQ + i; else if (i < 128) j = (rst + i / 16) * GRIDW + cst + i % 16; else j = SEQ + (i - 128);
            o = fmaf(sc[i], V[(size_t)j * ldv + tid], o); } oref[tid] = o / l; }
    __syncthreads();
    if (tid == 0) { float om = 0.f, df = 0.f; for (int d = 0; d < 128; ++d) { om = fmaxf(om, fabsf(oref[d])); df = fmaxf(df, fabsf(oref[d] - bf2f(O[(size_t)row * DM + h * 128 + d]))); }
        float e = df / (om + 1e-30f); if (!(e == e)) e = 50.f; atomicMax(errbits, __float_as_uint(e)); }
}
__global__ void pb_encode(const unsigned* errbits, float* out) { float e = __uint_as_float(*errbits); e = fminf(fmaxf(e, 1e-7f), 90.f); out[0] = e * 1e9f; }
#endif
extern "C" void kernel_launch(void* const* d_in, const int* in_sizes, int n_in, void* d_out, int out_size, void* d_ws, size_t ws_size, hipStream_t stream) {
    static int grid = 0;
    if (grid == 0) {
        if (n_in != NIN || in_sizes[0] != NLAT * DM || out_size != NLAT * DM || ws_size < WS_END) {
            fprintf(stderr, "kernel_launch: shape mismatch: n_in %d in0 %d out %d ws %zu (need >= %zu)\n", n_in, n_in > 0 ? in_sizes[0] : -1, out_size, ws_size, (size_t)WS_END); grid = -1; return; }
        int dev = 0, cus = 0, per_cu = 0;
        if (hipGetDevice(&dev) != hipSuccess || hipDeviceGetAttribute(&cus, hipDeviceAttributeMultiprocessorCount, dev) != hipSuccess) { fprintf(stderr, "kernel_launch: device query failed\n"); grid = -1; return; }
        if (hipFuncSetAttribute((const void*)mega_fwd, hipFuncAttributeMaxDynamicSharedMemorySize, LDS_BYTES) != hipSuccess) { fprintf(stderr, "kernel_launch: hipFuncSetAttribute failed\n"); grid = -1; return; }
        if (hipOccupancyMaxActiveBlocksPerMultiprocessor(&per_cu, (const void*)mega_fwd, 512, LDS_BYTES) != hipSuccess || per_cu < 1)
            fprintf(stderr, "kernel_launch: note: occupancy query reports %d workgroups per CU\n", per_cu);
        (void)hipGetLastError();
        grid = cus;
    }
    if (grid < 0) return;
    if (hipMemsetAsync((char*)d_ws + WS_CTL, 0, CTL_ZERO_BYTES, stream) != hipSuccess) { fprintf(stderr, "kernel_launch: memset failed\n"); return; }
    Args a{};
    for (int i = 0; i < NIN; ++i) a.in[i] = (const float*)d_in[i];
    a.out = (float*)d_out; a.ws = (unsigned char*)d_ws; a.rep_mask = RP_MASK;
#if MK_PER_PHASE
    for (int ph = 0; ph < NPH; ++ph) {
        if (!phase_exists(ph)) continue;
        a.ph_lo = ph; a.ph_hi = ph + 1;
        hipLaunchKernelGGL(mega_fwd, dim3(grid), dim3(512), LDS_BYTES, stream, a);
    }
#elif PROBE_LAYER >= 0
    {
        constexpr int L = PROBE_LAYER, kind = L % 3, jm = L / 3; constexpr bool wctx = (L != DEPTH - 1);
        a.ph_lo = 0; a.ph_hi = 1 + L * PPL + 6;
        hipLaunchKernelGGL(mega_fwd, dim3(grid), dim3(512), LDS_BYTES, stream, a);
        unsigned char* ws = (unsigned char*)d_ws; const bf16_t* H = (const bf16_t*)(ws + WS_H); const bf16_t* O = (const bf16_t*)(ws + WS_O);
        float* R0 = (float*)(ws + WS_END); float* R1 = R0 + (size_t)16640 * 576; float* R2 = R1 + (size_t)16640 * 256; float* R3 = R2 + (size_t)PB_NS * 512; float* SC = R3 + (size_t)PB_NS * 192;
        unsigned* err = (unsigned*)((unsigned char*)d_ws + 512 * 1024);
        const int NK = SEQ + CTXL;
        auto nb = [](long n) { return (unsigned)((n + 255) / 256); };
        hipMemsetAsync(d_out, 0, (size_t)out_size * 4, stream);
        if (kind == 2) { const int b = 1, h = 9, kvh = 2; const float* W = (const float*)d_in[22];
            hipLaunchKernelGGL(pb_proj, dim3(nb((long)NK * 128)), dim3(256), 0, stream, H, NK, 0, b, 1, W, 3072, 2048 + kvh * 128, 128, R0, 128);
            hipLaunchKernelGGL(pb_proj, dim3(nb((long)NK * 128)), dim3(256), 0, stream, H, NK, 0, b, 1, W, 3072, 2560 + kvh * 128, 128, R1, 128);
            hipLaunchKernelGGL(pb_normrope, dim3(nb(NK)), dim3(256), 0, stream, R0, 128, NK, 0, b, 1, 0, 128, (const float*)d_in[24], 0, 128);
            hipLaunchKernelGGL(pb_proj, dim3(nb((long)PB_NS * 128)), dim3(256), 0, stream, H, PB_NS, 1, b, 1, W, 3072, h * 128, 128, R2, 128);
            hipLaunchKernelGGL(pb_normrope, dim3(nb(PB_NS)), dim3(256), 0, stream, R2, 128, PB_NS, 1, b, 1, 0, 128, (const float*)d_in[23], 0, 128);
            hipLaunchKernelGGL(pb_attn, dim3(PB_NS), dim3(256), 0, stream, R2, 128, 128, 0, R0, 128, (const float*)nullptr, 0, R1, 128, 0.088388347648318440f, 0, (const float*)nullptr, O, b, h, 1, SC, err);
        } else if (kind == 1) { const int b = 0, h = 5;
            hipLaunchKernelGGL(pb_proj, dim3(nb((long)NK * 576)), dim3(256), 0, stream, H, NK, 0, b, 1, (const float*)d_in[18], 576, 0, 576, R0, 576);
            hipLaunchKernelGGL(pb_normrope, dim3(nb(NK)), dim3(256), 0, stream, R0, 576, NK, 0, b, 1, 0, 512, (const float*)d_in[19], 512, 64);
            hipLaunchKernelGGL(pb_proj_f32, dim3(nb((long)NK * 256)), dim3(256), 0, stream, R0, 576, 512, NK, (const float*)d_in[20], 4096, h * 256, 256, R1, 256);
            hipLaunchKernelGGL(pb_proj, dim3(nb((long)PB_NS * 512)), dim3(256), 0, stream, H, PB_NS, 1, b, 1, (const float*)d_in[15], 512, 0, 512, R2, 512);
            hipLaunchKernelGGL(pb_normrope, dim3(nb(PB_NS)), dim3(256), 0, stream, R2, 512, PB_NS, 1, b, 1, 0, 512, (const float*)d_in[16], 0, 0);
            hipLaunchKernelGGL(pb_proj_f32, dim3(nb((long)PB_NS * 192)), dim3(256), 0, stream, R2, 512, 512, PB_NS, (const float*)d_in[17], 3072, h * 192, 192, R3, 192);
            hipLaunchKernelGGL(pb_normrope, dim3(nb(PB_NS)), dim3(256), 0, stream, R3, 192, PB_NS, 1, b, 1, 0, 0, (const float*)nullptr, 128, 64);
            hipLaunchKernelGGL(pb_attn, dim3(PB_NS), dim3(256), 0, stream, R3, 192, 128, 64, R1, 256, R0 + 512, 576, R1 + 128, 256, 0.072168783648703220f, 0, (const float*)nullptr, O, b, h, 1, SC, err);
        } else { const int b = 1, h = 3; const float* W = (const float*)d_in[12] + (size_t)jm * DM * 6144;
            hipLaunchKernelGGL(pb_proj, dim3(nb((long)NK * 128)), dim3(256), 0, stream, H, NK, 0, b, wctx ? 1 : 0, W, 6144, 2048 + h * 128, 128, R0, 128);
            hipLaunchKernelGGL(pb_proj, dim3(nb((long)NK * 128)), dim3(256), 0, stream, H, NK, 0, b, wctx ? 1 : 0, W, 6144, 4096 + h * 128, 128, R1, 128);
            hipLaunchKernelGGL(pb_proj, dim3(nb((long)PB_NS * 128)), dim3(256), 0, stream, H, PB_NS, 1, b, wctx ? 1 : 0, W, 6144, h * 128, 128, R2, 128);
            hipLaunchKernelGGL(pb_attn, dim3(PB_NS), dim3(256), 0, stream, R2, 128, 128, 0, R0, 128, (const float*)nullptr, 0, R1, 128, 0.088388347648318440f, 2, (const float*)d_in[13] + ((size_t)jm * 16 + h) * 465, O, b, h, wctx ? 1 : 0, SC, err);
        }
        hipLaunchKernelGGL(pb_encode, dim3(1), dim3(1), 0, stream, (const unsigned*)err, (float*)d_out);
    }
#else
    a.ph_lo = 0; a.ph_hi = NPH;
    hipLaunchKernelGGL(mega_fwd, dim3(grid), dim3(512), LDS_BYTES, stream, a);
#endif
    const hipError_t le = hipPeekAtLastError();
    if (le != hipSuccess) fprintf(stderr, "kernel_launch: launch failed: %s\n", hipGetErrorName(le));
}
```

```cpp
#include <hip/hip_runtime.h>
#include <cstdio>
#include <cstdint>

#ifndef MK_PER_PHASE
#define MK_PER_PHASE 0
#endif

#ifndef EN_MASK
#define EN_MASK 0xFFFFFFFFu
#endif
#define EN(b) ((EN_MASK >> (b)) & 1u)
#ifndef RP_MASK
#define RP_MASK 0u
#endif
#define RPT(b) (1 + (int)((ap->rep_mask >> (b)) & 1u))
#define LAS __attribute__((address_space(3)))
typedef unsigned short bf16_t;
typedef short bf16x8 __attribute__((ext_vector_type(8)));
typedef short s16x4 __attribute__((ext_vector_type(4)));
typedef float f32x4 __attribute__((ext_vector_type(4)));
typedef float f32x2 __attribute__((ext_vector_type(2)));
typedef float f32x16 __attribute__((ext_vector_type(16)));
typedef unsigned u32x4 __attribute__((ext_vector_type(4)));
typedef unsigned u32x2 __attribute__((ext_vector_type(2)));

constexpr int DM = 2048, NBATCH = 2, SEQ = 16384, CTXL = 256, GRIDW = 64;
constexpr int NLAT = NBATCH * SEQ;
constexpr int MROWS = NLAT + NBATCH * CTXL;
constexpr int FFD = 5632, DEPTH = 4, MODW = 6 * DM;
constexpr float NORM_EPS = 1e-6f;
constexpr float LOG2E = 1.4426950408889634f;
constexpr int NBLK64 = MROWS / 64;

constexpr size_t MiB = 1u << 20;
constexpr size_t WS_CTL = 0, CTL_ZERO_BYTES = 1 * MiB;
constexpr size_t WS_MODS = 1 * MiB;
constexpr size_t WS_TAB = 2 * MiB;
constexpr size_t WS_RS = 3 * MiB;
constexpr size_t WS_X = 4 * MiB;
constexpr size_t WS_H = 264 * MiB;
constexpr size_t WS_O = 394 * MiB;
constexpr size_t WS_BIG = 524 * MiB;
constexpr size_t WS_W = 1068 * MiB;
constexpr size_t WS_PART = 1436 * MiB;
constexpr size_t WS_END = 1524 * MiB;
constexpr int WO_KS = 8, DN_KS = 22;
constexpr size_t BIG_QKV = 0;
constexpr size_t BIG_T1 = 0, BIG_Q = 82 * MiB, BIG_KV = 277 * MiB, BIG_KPE = 537 * MiB;
constexpr size_t BIG_ACT = 0, BIG_SIDE = 358 * MiB;
constexpr size_t SIDE_ARR = (size_t)NBLK64 * FFD;
constexpr size_t W_UP = 0, W_DN = 176 * MiB, W_NAQKV = 264 * MiB, W_NAWO = 312 * MiB, W_MLA1 = 328 * MiB, W_MLAQB = 333 * MiB,
                 W_MLAKVB = 336 * MiB, W_MLAWO = 340 * MiB, W_GQAQKV = 348 * MiB, W_GQAWO = 360 * MiB;
constexpr size_t W_UP_L = 44 * MiB, W_DN_L = 22 * MiB, W_NAQKV_L = 24 * MiB, W_NAWO_L = 8 * MiB;
constexpr int CW_BAR = 4096;

constexpr int RING_BYTES = 150528;
constexpr int LDSCTL_OFF = RING_BYTES, MISC_OFF = LDSCTL_OFF + 320, NATAB_OFF = LDSCTL_OFF + 1024;
constexpr int LDS_BYTES = RING_BYTES + 8192;

__device__ __forceinline__ unsigned cvt_pk_bf16(float lo, float hi) { unsigned r; asm volatile("v_cvt_pk_bf16_f32 %0, %1, %2" : "=v"(r) : "v"(lo), "v"(hi)); return r; }
__device__ __forceinline__ float bf_lo(unsigned w) { return __uint_as_float(w << 16); }
__device__ __forceinline__ float bf_hi(unsigned w) { return __uint_as_float(w & 0xffff0000u); }
__device__ __forceinline__ float bf2f(bf16_t b) { return __uint_as_float(((unsigned)b) << 16); }
__device__ __forceinline__ bf16_t f2bf(float f) { return (bf16_t)(cvt_pk_bf16(f, 0.f) & 0xffffu); }
__device__ __forceinline__ float wave_sum(float v) {
#pragma unroll
    for (int o = 1; o < 64; o <<= 1) v += __shfl_xor(v, o);
    return v;
}
__device__ __forceinline__ float silu_f(float c) { return c * __builtin_amdgcn_rcpf(1.0f + __builtin_amdgcn_exp2f(-c * LOG2E)); }
__device__ __forceinline__ int row_midx(int row) { return row < SEQ ? 0 : (row < NLAT ? 1 : 2); }

namespace pg8 {
constexpr int BM = 256, BK = 64, HALF = 128, HTB = HALF * BK * 2, STAGE_BYTES = 8 * HTB, NXCD = 8, WGM = 8;
__host__ __device__ __forceinline__ int lds_byte(int r, int c) { const int st = (r >> 4) * 2 + (c >> 5), rr = r & 15, cc = c & 31, ob = rr * 64 + cc * 2; return st * 1024 + (ob ^ (((ob >> 9) & 1) << 5)); }
__host__ __device__ __forceinline__ void stage_rc(int b, int& R, int& C) { const int st = b / 1024, sb = b % 1024, swz = sb ^ (((sb >> 9) & 1) << 5); R = (st >> 1) * 16 + swz / 64; C = (st & 1) * 32 + (swz % 64) / 2; }
__host__ __device__ __forceinline__ int perm32(int rho) { const int n = rho >> 4, i = rho & 15; return 8 * (i >> 2) + 4 * n + (i & 3); }

struct Unit { int pm, pn, k0, nt, kc; };
struct Gemm { const bf16_t* A; const bf16_t* Bt; int M, N, K, lda; };

struct StaticOrder {
    int nM, nN, nwg, G, c, ntf, nMs, KS, ntc;
    __device__ __forceinline__ void init(int Mf, int N, int K, int G_, int c_, int Ms = 0, int KS_ = 1) { nM = Mf / BM; nN = N / BM; nwg = nM * nN; G = G_; c = c_; ntf = K / BK; nMs = Ms / BM; KS = KS_; ntc = ntf / KS_; }
    __device__ __forceinline__ bool next(int i, Unit& u) const {
        const long L = (long)i * G + c;
        const bool split = L >= nwg;
        if (split && (int)(L - nwg) >= nMs * nN * KS) return false;
        int wgid = split ? 0 : (int)L; { const int q = nwg / NXCD, r = nwg % NXCD, xcd = wgid % NXCD, off = wgid / NXCD; wgid = (xcd < r ? xcd * (q + 1) : r * (q + 1) + (xcd - r) * q) + off; }
        const int nig = WGM * nN, gid = wgid / nig, fm = gid * WGM, gsz = (nM - fm) < WGM ? (nM - fm) : WGM;
        const int pm_f = fm + ((wgid % nig) % gsz), pn_f = (wgid % nig) / gsz;
        const int sidx = split ? (int)(L - nwg) : 0, kc_s = sidx % KS, t = sidx / KS, pn_s = t % nN, pm_s = nM + t / nN;
        u.pm = split ? pm_s : pm_f; u.pn = split ? pn_s : pn_f; u.k0 = split ? kc_s * ntc * BK : 0; u.nt = split ? ntc : ntf; u.kc = split ? kc_s : -1;
        return true;
    }
};

template <bool SCALED> struct EpiBf16 {
    static constexpr bool PERM = true;
    bf16_t* O; int ldc; const float* rs; int rsel; float mul;
    __device__ __forceinline__ void operator()(const f32x4 (&acc)[2][2][4][2], const Unit& u, int wr, int wc, int fr, int fq) const {
        const int row0 = u.pm * BM + wr * 64 + fr, col0 = u.pn * BM + wc * 32 + 8 * fq;
#pragma unroll
        for (int ai = 0; ai < 2; ++ai)
#pragma unroll
            for (int m = 0; m < 4; ++m) { const int row = row0 + ai * HALF + m * 16; bf16_t* rowp = O + (size_t)row * ldc + col0;
                float sc = 1.0f; if constexpr (SCALED) sc = rs[(size_t)row * 2 + rsel] * mul;
#pragma unroll
                for (int bj = 0; bj < 2; ++bj) { const f32x4 v0 = acc[ai][bj][m][0] * sc, v1 = acc[ai][bj][m][1] * sc;
                    u32x4 w; w.x = cvt_pk_bf16(v0[0], v0[1]); w.y = cvt_pk_bf16(v0[2], v0[3]); w.z = cvt_pk_bf16(v1[0], v1[1]); w.w = cvt_pk_bf16(v1[2], v1[3]);
                    *(u32x4*)(rowp + bj * HALF) = w; }
                if constexpr (SCALED) asm volatile("" ::: "memory"); }
    }
};
struct EpiResid {
    static constexpr bool PERM = false;
    float* X; const float* gate; float* part;
    __device__ __forceinline__ void operator()(const f32x4 (&acc)[2][2][4][2], const Unit& u, int wr, int wc, int fr, int fq) const {
        if (u.kc >= 0) {
            const int rl0 = (u.pm - NLAT / BM) * BM + wr * 64 + fr, col0 = u.pn * BM + wc * 32 + 4 * fq;
#pragma unroll
            for (int ai = 0; ai < 2; ++ai)
#pragma unroll
                for (int m = 0; m < 4; ++m) { float* rowp = part + ((size_t)u.kc * (NBATCH * CTXL) + rl0 + ai * HALF + m * 16) * DM + col0;
#pragma unroll
                    for (int bj = 0; bj < 2; ++bj)
#pragma unroll
                        for (int n = 0; n < 2; ++n) *(f32x4*)(rowp + bj * HALF + n * 16) = acc[ai][bj][m][n]; }
            return;
        }
        const int midx = u.pm < 64 ? 0 : (u.pm < 128 ? 1 : 2);
        const float* g = gate + (size_t)midx * MODW;
        const int row0 = u.pm * BM + wr * 64 + fr, col0 = u.pn * BM + wc * 32 + 4 * fq;
        f32x4 gv[2][2];
#pragma unroll
        for (int bj = 0; bj < 2; ++bj)
#pragma unroll
            for (int n = 0; n < 2; ++n) gv[bj][n] = *(const f32x4*)(g + col0 + bj * HALF + n * 16);
#pragma unroll
        for (int ai = 0; ai < 2; ++ai)
#pragma unroll
            for (int m = 0; m < 4; ++m) { float* rowp = X + (size_t)(row0 + ai * HALF + m * 16) * DM + col0;
#pragma unroll
                for (int bj = 0; bj < 2; ++bj)
#pragma unroll
                    for (int n = 0; n < 2; ++n) { float* p = rowp + bj * HALF + n * 16; const f32x4 x = *(const f32x4*)p; *(f32x4*)p = x + gv[bj][n] * acc[ai][bj][m][n]; } }
    }
};
struct EpiGlu {
    static constexpr bool PERM = true;
    bf16_t* ACT; const float* cw; const float* cb; float* side;
    __device__ __forceinline__ void operator()(const f32x4 (&acc)[2][2][4][2], const Unit& u, int wr, int wc, int fr, int fq) const {
        const int ch0 = u.pn * HALF + wc * 32 + 8 * fq;
        const int lane = (int)(threadIdx.x & 63);
        const int src_prev = (lane & 48) | ((fr + 15) & 15), src_next = (lane & 48) | ((fr + 1) & 15);
#pragma unroll
        for (int ai = 0; ai < 2; ++ai) {
            const int blk = u.pm * 4 + ai * 2 + wr;
            unsigned pk[4][4];
#pragma unroll
            for (int n = 0; n < 2; ++n) {
                const f32x4 w0 = *(const f32x4*)(cw + ch0 + 4 * n), w1 = *(const f32x4*)(cw + FFD + ch0 + 4 * n), w2 = *(const f32x4*)(cw + 2 * FFD + ch0 + 4 * n), bb = *(const f32x4*)(cb + ch0 + 4 * n);
                f32x4 R[4], Lr[4];
#pragma unroll
                for (int m = 0; m < 4; ++m)
#pragma unroll
                    for (int j = 0; j < 4; ++j) { const float g = acc[ai][0][m][n][j]; R[m][j] = __shfl(g, src_prev); Lr[m][j] = __shfl(g, src_next); }
#pragma unroll
                for (int m = 0; m < 4; ++m) {
                    f32x4 prev = R[m], next = Lr[m];
                    if (fr == 0) prev = (m > 0) ? R[m > 0 ? m - 1 : 0] : (f32x4){0.f, 0.f, 0.f, 0.f};
                    if (fr == 15) next = (m < 3) ? Lr[m < 3 ? m + 1 : 3] : (f32x4){0.f, 0.f, 0.f, 0.f};
                    const f32x4 g = acc[ai][0][m][n], v = acc[ai][1][m][n];
                    const f32x4 c = bb + w0 * prev + w1 * g + w2 * next;
                    float a[4];
#pragma unroll
                    for (int j = 0; j < 4; ++j) a[j] = silu_f(c[j]) * v[j];
                    pk[m][2 * n] = cvt_pk_bf16(a[0], a[1]); pk[m][2 * n + 1] = cvt_pk_bf16(a[2], a[3]);
                }
            }
#pragma unroll
            for (int m = 0; m < 4; ++m) {
                const int row = u.pm * BM + ai * HALF + wr * 64 + m * 16 + fr;
                u32x4 w; w.x = pk[m][0]; w.y = pk[m][1]; w.z = pk[m][2]; w.w = pk[m][3];
                const bool edge = (m == 0 && fr == 0) || (m == 3 && fr == 15);
                if (!edge) *(u32x4*)(ACT + (size_t)row * FFD + ch0) = w;
            }
            float* sb = side + (size_t)blk * FFD + ch0;
            if (fr == 0)  { *(f32x4*)(sb + 0 * SIDE_ARR) = acc[ai][0][0][0]; *(f32x4*)(sb + 0 * SIDE_ARR + 4) = acc[ai][0][0][1]; *(f32x4*)(sb + 4 * SIDE_ARR) = acc[ai][1][0][0]; *(f32x4*)(sb + 4 * SIDE_ARR + 4) = acc[ai][1][0][1]; }
            if (fr == 1)  { *(f32x4*)(sb + 1 * SIDE_ARR) = acc[ai][0][0][0]; *(f32x4*)(sb + 1 * SIDE_ARR + 4) = acc[ai][0][0][1]; }
            if (fr == 14) { *(f32x4*)(sb + 2 * SIDE_ARR) = acc[ai][0][3][0]; *(f32x4*)(sb + 2 * SIDE_ARR + 4) = acc[ai][0][3][1]; }
            if (fr == 15) { *(f32x4*)(sb + 3 * SIDE_ARR) = acc[ai][0][3][0]; *(f32x4*)(sb + 3 * SIDE_ARR + 4) = acc[ai][0][3][1]; *(f32x4*)(sb + 5 * SIDE_ARR) = acc[ai][1][3][0]; *(f32x4*)(sb + 5 * SIDE_ARR + 4) = acc[ai][1][3][1]; }
        }
    }
};

template <class Epi>
__device__ __forceinline__ void gemm_phase(LAS unsigned char* lds, const Gemm g, const StaticOrder& S, const Epi& E) {
    int tid = threadIdx.x; asm volatile("" : "+v"(tid));
    const int wid = __builtin_amdgcn_readfirstlane(tid >> 6), lane = tid & 63, wr = wid >> 2, wc = wid & 3, fr = lane & 15, fq = lane >> 4;
    const int K = g.K, lda = g.lda;
    unsigned voffA[2], voffB[2];
#pragma unroll
    for (int i = 0; i < 2; ++i) { int R, C; stage_rc(tid * 16 + i * 8192, R, C); const int Rb = Epi::PERM ? ((R & ~31) + perm32(R & 31)) : R;
        voffA[i] = (unsigned)(R * lda + C) * 2u; voffB[i] = (unsigned)(Rb * K + C) * 2u; }
    const size_t kstep = (size_t)(BK * 2);
    const size_t hA = (size_t)HALF * lda * 2, hB = (size_t)HALF * K * 2;
    const size_t tA = 2 * hA, tB = 2 * hB;
    const unsigned ldsw = (unsigned)wid * 1024u;
    const int aoff = lds_byte(wr * 64 + fr, fq * 8), boff = lds_byte(wc * 32 + fr, fq * 8);
#define PG8_SA(b, h) (((b) * 2 + (h)) * HTB)
#define PG8_SB(b, h) ((4 + (b) * 2 + (h)) * HTB)
#define PG8_STAGE(bufoff, gbase, voff) do { _Pragma("unroll") for (int _i = 0; _i < 2; ++_i) \
        __builtin_amdgcn_global_load_lds((const unsigned*)((const char*)(gbase) + (voff)[_i]), (LAS unsigned*)(lds + (bufoff) + ldsw + _i * 8192), 16, 0, 0); } while (0)
#define PG8_LDA(dst, b, h) do { _Pragma("unroll") for (int m = 0; m < 4; ++m) _Pragma("unroll") for (int k = 0; k < 2; ++k) dst[m][k] = *(const LAS bf16x8*)(lds + PG8_SA(b, h) + aoff + m * 2048 + k * 1024); } while (0)
#define PG8_LDB(dst, b, h) do { _Pragma("unroll") for (int n = 0; n < 2; ++n) _Pragma("unroll") for (int k = 0; k < 2; ++k) dst[n][k] = *(const LAS bf16x8*)(lds + PG8_SB(b, h) + boff + n * 2048 + k * 1024); } while (0)
#define PG8_MMA(ai, bj, At, Bt) do { __builtin_amdgcn_s_setprio(1); _Pragma("unroll") for (int m = 0; m < 4; ++m) _Pragma("unroll") for (int n = 0; n < 2; ++n) _Pragma("unroll") for (int k = 0; k < 2; ++k) \
        acc[ai][bj][m][n] = __builtin_amdgcn_mfma_f32_16x16x32_bf16(Bt[n][k], At[m][k], acc[ai][bj][m][n], 0, 0, 0); __builtin_amdgcn_s_setprio(0); } while (0)
#define PG8_WAIT_V(n) asm volatile("s_waitcnt vmcnt(" #n ")" ::: "memory")
#define PG8_WAIT_L(n) asm volatile("s_waitcnt lgkmcnt(" #n ")" ::: "memory")
#define PG8_BAR __builtin_amdgcn_s_barrier()
#define PG8_SCHED __builtin_amdgcn_sched_barrier(0)
    Unit cur, nxt; int ui = 0;
    if (!S.next(0, cur)) return;
    f32x4 acc[2][2][4][2];
#pragma unroll
    for (int a = 0; a < 2; ++a)
#pragma unroll
        for (int b = 0; b < 2; ++b)
#pragma unroll
            for (int m = 0; m < 4; ++m)
#pragma unroll
                for (int n = 0; n < 2; ++n) acc[a][b][m][n] = (f32x4){0.f, 0.f, 0.f, 0.f};
    bf16x8 At[4][2], B0[2][2], B1[2][2];
    const char* cA = (const char*)g.A + (size_t)cur.pm * tA + (size_t)cur.k0 * 2; const char* cB = (const char*)g.Bt + (size_t)cur.pn * tB + (size_t)cur.k0 * 2;
    PG8_STAGE(PG8_SB(0, 0), cB, voffB); PG8_STAGE(PG8_SB(0, 1), cB + hB, voffB); PG8_STAGE(PG8_SA(0, 0), cA, voffA); PG8_STAGE(PG8_SA(0, 1), cA + hA, voffA);
    if (wr == 1) PG8_BAR;
    PG8_WAIT_V(2); PG8_BAR;
    PG8_STAGE(PG8_SB(1, 0), cB + kstep, voffB); PG8_STAGE(PG8_SA(1, 0), cA + kstep, voffA); PG8_STAGE(PG8_SB(1, 1), cB + hB + kstep, voffB);
    PG8_WAIT_V(6); PG8_BAR;
    for (;;) {
        const bool has_next = S.next(ui + 1, nxt);
        const char* nA = has_next ? (const char*)g.A + (size_t)nxt.pm * tA + (size_t)nxt.k0 * 2 : cA; const char* nB = has_next ? (const char*)g.Bt + (size_t)nxt.pn * tB + (size_t)nxt.k0 * 2 : cB;
        const int nt = cur.nt;
        for (int t = 0; t < nt; t += 2) {
            const bool last = (t == nt - 2);
            const char* a1 = cA + (size_t)(t + 1) * kstep;
            const char* a2 = last ? nA : cA + (size_t)(t + 2) * kstep; const char* b2 = last ? nB : cB + (size_t)(t + 2) * kstep;
            const char* a3 = a2 + kstep; const char* b3 = b2 + kstep;
            PG8_LDB(B0, 0, 0); PG8_LDB(B1, 0, 1); PG8_SCHED; PG8_LDA(At, 0, 0); PG8_STAGE(PG8_SA(1, 1), a1 + hA, voffA);
            PG8_WAIT_V(8); PG8_WAIT_L(0); PG8_BAR; PG8_MMA(0, 0, At, B0); PG8_MMA(0, 1, At, B1); PG8_BAR; PG8_SCHED;
            PG8_LDA(At, 0, 1); PG8_STAGE(PG8_SB(0, 0), b2, voffB); PG8_STAGE(PG8_SB(0, 1), b2 + hB, voffB); PG8_STAGE(PG8_SA(0, 0), a2, voffA);
            PG8_WAIT_V(8); PG8_WAIT_L(0); PG8_BAR; PG8_MMA(1, 0, At, B0); PG8_MMA(1, 1, At, B1); PG8_BAR; PG8_SCHED;
            PG8_LDB(B0, 1, 0); PG8_LDB(B1, 1, 1); PG8_SCHED; PG8_LDA(At, 1, 0); PG8_STAGE(PG8_SA(0, 1), a2 + hA, voffA);
            PG8_WAIT_V(8); PG8_WAIT_L(0); PG8_BAR; PG8_MMA(0, 0, At, B0); PG8_MMA(0, 1, At, B1); PG8_BAR; PG8_SCHED;
            PG8_LDA(At, 1, 1); PG8_STAGE(PG8_SB(1, 0), b3, voffB); PG8_STAGE(PG8_SB(1, 1), b3 + hB, voffB); PG8_STAGE(PG8_SA(1, 0), a3, voffA);
            PG8_WAIT_V(8); PG8_WAIT_L(0); PG8_BAR; PG8_MMA(1, 0, At, B0); PG8_MMA(1, 1, At, B1); PG8_BAR; PG8_SCHED;
        }
        if (wr == 0) PG8_BAR;
        E(acc, cur, wr, wc, fr, fq);
        if (!has_next) break;
#pragma unroll
        for (int a = 0; a < 2; ++a)
#pragma unroll
            for (int b = 0; b < 2; ++b)
#pragma unroll
                for (int m = 0; m < 4; ++m)
#pragma unroll
                    for (int n = 0; n < 2; ++n) acc[a][b][m][n] = (f32x4){0.f, 0.f, 0.f, 0.f};
        cur = nxt; cA = nA; cB = nB; ++ui;
        if (wr == 1) PG8_BAR;
    }
    PG8_WAIT_V(0);
    PG8_BAR;
#undef PG8_SA
#undef PG8_SB
#undef PG8_STAGE
#undef PG8_LDA
#undef PG8_LDB
#undef PG8_MMA
#undef PG8_WAIT_V
#undef PG8_WAIT_L
#undef PG8_BAR
#undef PG8_SCHED
}
}

namespace att {
#define SBAR() __builtin_amdgcn_sched_barrier(0)
__device__ __forceinline__ int crow(int r, int hi) { return (r & 3) + 8 * (r >> 2) + 4 * hi; }
template <int DK> __device__ __forceinline__ int kswz(int row, int colB) {
    if (DK == 128) return row * 256 + (colB ^ (((row & 7) << 4) | (((row >> 3) & 1) << 7)));
    else return row * 384 + (colB ^ (((row >> 1) & 7) << 4));
}
template <int DK> struct Sc { static constexpr float SCALE = (DK == 128) ? 0.088388347648318440f : 0.072168783648703220f; };
constexpr float THR = 8.f;

template <int DK>
__device__ __forceinline__ void partialSM(f32x16& p0, f32x16& p1, float& m_reg, float& mn, float& alpha) {
    constexpr float SCALE = Sc<DK>::SCALE, C = SCALE * LOG2E;
    float pmax = p0[0];
#pragma unroll
    for (int r = 1; r < 16; ++r) pmax = fmaxf(pmax, p0[r]);
#pragma unroll
    for (int r = 0; r < 16; ++r) pmax = fmaxf(pmax, p1[r]);
    { auto rr = __builtin_amdgcn_permlane32_swap(__float_as_uint(pmax), __float_as_uint(pmax), false, false);
      pmax = fmaxf(__uint_as_float(rr[0]), __uint_as_float(rr[1])); }
    if (__builtin_expect(__all(pmax - m_reg <= THR / SCALE), 1)) { mn = m_reg; alpha = 1.f; }
    else { mn = fmaxf(m_reg, pmax); alpha = __builtin_amdgcn_exp2f((m_reg - mn) * C); m_reg = mn; }
    const float mnC = -mn * C;
#pragma unroll
    for (int r = 0; r < 16; ++r) p0[r] = fmaf(p0[r], C, mnC);
#pragma unroll
    for (int r = 0; r < 16; ++r) p1[r] = fmaf(p1[r], C, mnC);
#pragma unroll
    for (int r = 0; r < 16; ++r) p0[r] = __builtin_amdgcn_exp2f(p0[r]);
}
__device__ __forceinline__ void finishSM(f32x16& p0, f32x16& p1, float alpha, float& l_reg, bf16x8& pa0, bf16x8& pa1, bf16x8& pa2, bf16x8& pa3) {
#pragma unroll
    for (int r = 0; r < 16; ++r) p1[r] = __builtin_amdgcn_exp2f(p1[r]);
    float ps = 0;
#pragma unroll
    for (int r = 0; r < 16; ++r) ps += p0[r];
#pragma unroll
    for (int r = 0; r < 16; ++r) ps += p1[r];
    { auto rr = __builtin_amdgcn_permlane32_swap(__float_as_uint(ps), __float_as_uint(ps), false, false);
      ps = __uint_as_float(rr[0]) + __uint_as_float(rr[1]); }
    l_reg = l_reg * alpha + ps;
#define PK4(P, BASE, OUT) do { unsigned a0 = cvt_pk_bf16(P[BASE + 0], P[BASE + 1]), a1 = cvt_pk_bf16(P[BASE + 2], P[BASE + 3]);   \
    unsigned b0 = cvt_pk_bf16(P[BASE + 4], P[BASE + 5]), b1 = cvt_pk_bf16(P[BASE + 6], P[BASE + 7]);                              \
    auto r0 = __builtin_amdgcn_permlane32_swap(a0, b0, false, false); auto r1 = __builtin_amdgcn_permlane32_swap(a1, b1, false, false); \
    u32x4 w = {r0[0], r1[0], r0[1], r1[1]}; OUT = *reinterpret_cast<bf16x8*>(&w); } while (0)
    PK4(p0, 0, pa0); PK4(p0, 8, pa1); PK4(p1, 0, pa2); PK4(p1, 8, pa3);
#undef PK4
}
template <int DK, int QL = 0, int PF = 1>
__device__ __forceinline__ void qkt(f32x16& p0, f32x16& p1, const LAS char* Ks, const bf16x8* qr, int r32, int hi, int qlds = 0) {
    p0 = f32x16{}; p1 = f32x16{};
    constexpr int ND = DK / 16;
    if constexpr (QL > 0) asm volatile("" : "+v"(qlds));
    if constexpr (PF <= 1) {
#pragma unroll
        for (int d0 = 0; d0 < ND; ++d0) { const int cb = (d0 * 16 + hi * 8) * 2;
            const bf16x8 b0 = *(const LAS bf16x8*)(Ks + kswz<DK>(r32, cb));
            const bf16x8 b1 = *(const LAS bf16x8*)(Ks + kswz<DK>(32 + r32, cb));
            bf16x8 q;
            if constexpr (QL > 0) { if (d0 >= ND - QL) q = *(const LAS bf16x8*)(uintptr_t)(unsigned)(qlds + (d0 - (ND - QL)) * 1024); else q = qr[d0]; }
            else q = qr[d0];
            p0 = __builtin_amdgcn_mfma_f32_32x32x16_bf16(b0, q, p0, 0, 0, 0);
            p1 = __builtin_amdgcn_mfma_f32_32x32x16_bf16(b1, q, p1, 0, 0, 0); }
    } else {
        bf16x8 kf[PF][2], qf[PF];
#pragma unroll
        for (int s = 0; s < PF; ++s) { const int cb = (s * 16 + hi * 8) * 2;
            kf[s][0] = *(const LAS bf16x8*)(Ks + kswz<DK>(r32, cb)); kf[s][1] = *(const LAS bf16x8*)(Ks + kswz<DK>(32 + r32, cb));
            if constexpr (QL > 0) { if (s >= ND - QL) qf[s] = *(const LAS bf16x8*)(uintptr_t)(unsigned)(qlds + (s - (ND - QL)) * 1024); } }
        SBAR();
#pragma unroll
        for (int d0 = 0; d0 < ND; ++d0) {
            bf16x8 q;
            if constexpr (QL > 0) { if (d0 >= ND - QL) q = qf[d0 % PF]; else q = qr[d0]; } else q = qr[d0];
            p0 = __builtin_amdgcn_mfma_f32_32x32x16_bf16(kf[d0 % PF][0], q, p0, 0, 0, 0);
            p1 = __builtin_amdgcn_mfma_f32_32x32x16_bf16(kf[d0 % PF][1], q, p1, 0, 0, 0);
            if (d0 + PF < ND) { const int s = d0 + PF; const int cb = (s * 16 + hi * 8) * 2;
                kf[d0 % PF][0] = *(const LAS bf16x8*)(Ks + kswz<DK>(r32, cb)); kf[d0 % PF][1] = *(const LAS bf16x8*)(Ks + kswz<DK>(32 + r32, cb));
                if constexpr (QL > 0) { if (s >= ND - QL) qf[d0 % PF] = *(const LAS bf16x8*)(uintptr_t)(unsigned)(qlds + (s - (ND - QL)) * 1024); } }
            SBAR();
        }
    }
}
__device__ __forceinline__ float bf16_rne(float x) { return __uint_as_float(cvt_pk_bf16(x, 0.f) << 16); }
__device__ __forceinline__ void partialSM_ps(f32x16& p0, f32x16& p1, float& m_off, float& alpha, bf16x8& qx, int hi, bool first) {
    float pmax = p0[0];
#pragma unroll
    for (int r = 1; r < 16; ++r) pmax = fmaxf(pmax, p0[r]);
#pragma unroll
    for (int r = 0; r < 16; ++r) pmax = fmaxf(pmax, p1[r]);
    { auto rr = __builtin_amdgcn_permlane32_swap(__float_as_uint(pmax), __float_as_uint(pmax), false, false);
      pmax = fmaxf(__uint_as_float(rr[0]), __uint_as_float(rr[1])); }
    if (__builtin_expect(!first && __all(pmax <= THR * LOG2E), 1)) { alpha = 1.f; }
    else {
        const float d = first ? pmax : fmaxf(pmax, 0.f);
        const float m_new = bf16_rne(m_off + d), delta = m_new - m_off;
        alpha = first ? 1.f : __builtin_amdgcn_exp2f(-delta); m_off = m_new;
#pragma unroll
        for (int r = 0; r < 16; ++r) { p0[r] -= delta; p1[r] -= delta; }
        const unsigned nb = (hi == 0) ? (cvt_pk_bf16(-m_new, 0.f) & 0xffffu) : 0u;
        u32x4 w = {nb, 0u, 0u, 0u}; qx = *reinterpret_cast<bf16x8*>(&w);
    }
#pragma unroll
    for (int r = 0; r < 16; ++r) p0[r] = __builtin_amdgcn_exp2f(p0[r]);
}
__device__ __forceinline__ void qk_offset_step(f32x16& p0, f32x16& p1, bf16x8 onesf, bf16x8 qx) {
    p0 = __builtin_amdgcn_mfma_f32_32x32x16_bf16(onesf, qx, p0, 0, 0, 0);
    p1 = __builtin_amdgcn_mfma_f32_32x32x16_bf16(onesf, qx, p1, 0, 0, 0);
}
__device__ __forceinline__ int v_st(int k, int c) { const int kk = (k & ~0xC) | ((k & 4) << 1) | ((k & 8) >> 1); return ((kk >> 3) * 4 + (c >> 5)) * 512 + ((kk & 7) * 32 + (c & 31)) * 2; }
__device__ __forceinline__ int v_rd_base(int lane) { return ((lane & 3) << 3) | (((lane >> 2) & 3) << 6) | (((lane >> 4) & 1) << 5) | (((lane >> 5) & 1) << 8); }
constexpr int v_rd_off(int d0, int ks, int half) { return d0 * 512 + ks * 4096 + half * 2048; }
template <int OFF> __device__ __forceinline__ s16x4 tr_read(int vb) {
    s16x4 r; asm volatile("ds_read_b64_tr_b16 %0, %1 offset:%2" : "=&v"(r) : "v"(vb), "i"(OFF) : "memory"); return r;
}
template <int D0> __device__ __forceinline__ void pv_one(f32x16& od, int vb, bf16x8 pa0, bf16x8 pa1, bf16x8 pa2, bf16x8 pa3) {
    const s16x4 l0 = tr_read<v_rd_off(D0, 0, 0)>(vb), h0 = tr_read<v_rd_off(D0, 0, 1)>(vb), l1 = tr_read<v_rd_off(D0, 1, 0)>(vb), h1 = tr_read<v_rd_off(D0, 1, 1)>(vb);
    const s16x4 l2 = tr_read<v_rd_off(D0, 2, 0)>(vb), h2 = tr_read<v_rd_off(D0, 2, 1)>(vb), l3 = tr_read<v_rd_off(D0, 3, 0)>(vb), h3 = tr_read<v_rd_off(D0, 3, 1)>(vb);
    asm volatile("s_waitcnt lgkmcnt(0)" ::: "memory"); SBAR();
#define PK(L, H) (bf16x8){L[0], L[1], L[2], L[3], H[0], H[1], H[2], H[3]}
    od = __builtin_amdgcn_mfma_f32_32x32x16_bf16(pa0, PK(l0, h0), od, 0, 0, 0);
    od = __builtin_amdgcn_mfma_f32_32x32x16_bf16(pa1, PK(l1, h1), od, 0, 0, 0);
    od = __builtin_amdgcn_mfma_f32_32x32x16_bf16(pa2, PK(l2, h2), od, 0, 0, 0);
    od = __builtin_amdgcn_mfma_f32_32x32x16_bf16(pa3, PK(l3, h3), od, 0, 0, 0);
#undef PK
}
__device__ __forceinline__ void pv_d0(f32x16* o, int vb, bf16x8 pa0, bf16x8 pa1, bf16x8 pa2, bf16x8 pa3) {
    pv_one<0>(o[0], vb, pa0, pa1, pa2, pa3); pv_one<1>(o[1], vb, pa0, pa1, pa2, pa3); pv_one<2>(o[2], vb, pa0, pa1, pa2, pa3); pv_one<3>(o[3], vb, pa0, pa1, pa2, pa3);
}

template <int DK, int SD, int QL, bool PS, int PF>
__device__ __forceinline__ void dense_body(const bf16_t* __restrict__ Qb, int ldq, const bf16_t* __restrict__ Kh, int ldk, const bf16_t* __restrict__ KPh,
                                           const bf16_t* __restrict__ Vh, int ldv, bf16_t* __restrict__ Ob, int ldo,
                                           int base0, int n0, int base1, int NT, LAS char* lds) {
    constexpr int SHM_V = 64 * 128 * 2, SHM_K = 64 * DK * 2, ND = DK / 16;
    int tid = threadIdx.x; asm volatile("" : "+v"(tid));
    const int wid = tid >> 6, lane = tid & 63, r32 = lane & 31, hi = lane >> 5;
    LAS char* V_lds = lds; LAS char* K_lds = lds + 2 * SHM_V;
    LAS float* ws = (LAS float*)(lds + 2 * SHM_V + 2 * SHM_K) + wid * 64; LAS float* li_l = ws; LAS float* al_l = ws + 32;
    float m_reg = -1e30f, l_reg = 0; f32x16 o[4] = {}; bf16x8 qr[ND - QL];
    const bf16_t* Qw = Qb + (long)(wid * 32 + r32) * ldq + hi * 8;
#pragma unroll
    for (int d0 = 0; d0 < ND - QL; ++d0) qr[d0] = *(const bf16x8*)(Qw + d0 * 16);
    const int qlds = (int)(unsigned)(uintptr_t)(lds + 2 * SHM_V + 2 * SHM_K + 2048) + wid * (QL * 1024) + lane * 16;
    if constexpr (QL > 0) {
#pragma unroll
        for (int d0 = ND - QL; d0 < ND; ++d0) *(LAS bf16x8*)(uintptr_t)(unsigned)(qlds + (d0 - (ND - QL)) * 1024) = *(const bf16x8*)(Qw + d0 * 16);
    }
    const int sr = tid >> 4, sc = (tid & 15) * 8, vst0 = v_st(sr, sc), vst1 = v_st(32 + sr, sc);
    const int pr = tid >> 3, pc = (tid & 7) * 8;
    const int kst0 = kswz<DK>(sr, sc * 2), kst1 = kswz<DK>(32 + sr, sc * 2), kstp = kswz<DK>(pr, 256 + pc * 2);
    const int vb0 = (int)(unsigned)(uintptr_t)V_lds + v_rd_base(lane);
    bf16x8 vs0, vs1, ks0, ks1, kp;
#define TROW(j) ((long)((j) < n0 ? base0 + (j) * 64 : base1 + ((j) - n0) * 64))
#define LOADK(j) do { const long r0_ = TROW(j); ks0 = *(const bf16x8*)(&Kh[(r0_ + sr) * ldk + sc]); ks1 = *(const bf16x8*)(&Kh[(r0_ + 32 + sr) * ldk + sc]); \
    if constexpr (DK == 192) kp = *(const bf16x8*)(&KPh[(r0_ + pr) * 64 + pc]); } while (0)
#define LOADV(j) do { const long r0_ = TROW(j); vs0 = *(const bf16x8*)(&Vh[(r0_ + sr) * ldv + sc]); vs1 = *(const bf16x8*)(&Vh[(r0_ + 32 + sr) * ldv + sc]); } while (0)
#define WRITEK(b) do { *(LAS bf16x8*)(K_lds + (b) * SHM_K + kst0) = ks0; *(LAS bf16x8*)(K_lds + (b) * SHM_K + kst1) = ks1; \
    if constexpr (DK == 192) *(LAS bf16x8*)(K_lds + (b) * SHM_K + kstp) = kp; } while (0)
#define WRITEV(b) do { *(LAS bf16x8*)(V_lds + (b) * SHM_V + vst0) = vs0; *(LAS bf16x8*)(V_lds + (b) * SHM_V + vst1) = vs1; } while (0)
#define VMW0() asm volatile("s_waitcnt vmcnt(0)" ::: "memory")
#define RESC(a) do { if (__any((a) < 1.f)) { if (hi == 0) al_l[r32] = (a); asm volatile("s_waitcnt lgkmcnt(0)" ::: "memory"); \
    _Pragma("unroll") for (int d = 0; d < 4; ++d) _Pragma("unroll") for (int r = 0; r < 16; ++r) o[d][r] *= al_l[crow(r, hi)]; } } while (0)
    f32x16 pA0, pA1, pB0, pB1; float mnA, mnB, alA, alB; bf16x8 pa0, pa1, pa2, pa3;
    bf16x8 qx = {0, 0, 0, 0, 0, 0, 0, 0}, onesf = {0, 0, 0, 0, 0, 0, 0, 0}; float m_off = 0.f;
    if constexpr (PS) { if (hi == 0) onesf[0] = (short)0x3F80; }
    (void)mnA; (void)mnB;
#define SCORES(P0, P1, KB) do { qkt<DK, QL, PF>(P0, P1, KB, qr, r32, hi, qlds); if constexpr (PS) qk_offset_step(P0, P1, onesf, qx); } while (0)
#define PSM(P0, P1, mnC, alC, FIRST) do { if constexpr (PS) partialSM_ps(P0, P1, m_off, alC, qx, hi, FIRST); else partialSM<DK>(P0, P1, m_reg, mnC, alC); } while (0)
#define ITER(j, PAR, PC0, PC1, mnC, alC, PP0, PP1, alP) do { \
    __syncthreads(); VMW0(); \
    if ((j) + 1 < NT) WRITEK(1 - (PAR)); \
    WRITEV(PAR); \
    SBAR(); SCORES(PC0, PC1, K_lds + (PAR) * SHM_K); \
    finishSM(PP0, PP1, alP, l_reg, pa0, pa1, pa2, pa3); SBAR(); \
    if ((j) + 2 < NT) LOADK((j) + 2); \
    if ((j) + 1 < NT) LOADV((j) + 1); \
    SBAR(); \
    pv_d0(o, vb0 + (1 - (PAR)) * SHM_V, pa0, pa1, pa2, pa3); PSM(PC0, PC1, mnC, alC, false); \
    RESC(alC); } while (0)
    LOADK(0); VMW0(); WRITEK(0);
    LOADK(1); LOADV(0); VMW0(); WRITEK(1); WRITEV(0);
    if (2 < NT) LOADK(2);
    LOADV(1);
    __syncthreads();
    SCORES(pA0, pA1, K_lds); PSM(pA0, pA1, mnA, alA, true);
    int j = 1;
    for (; j + 2 <= NT - 1; j += 2) {
        ITER(j, 1, pB0, pB1, mnB, alB, pA0, pA1, alA);
        ITER(j + 1, 0, pA0, pA1, mnA, alA, pB0, pB1, alB);
    }
    ITER(j, 1, pB0, pB1, mnB, alB, pA0, pA1, alA);
    __syncthreads();
    finishSM(pB0, pB1, alB, l_reg, pa0, pa1, pa2, pa3); SBAR();
    pv_d0(o, vb0 + SHM_V, pa0, pa1, pa2, pa3);
    if (hi == 0) li_l[r32] = l_reg; asm volatile("s_waitcnt lgkmcnt(0)" ::: "memory");
    float rli[16];
#pragma unroll
    for (int r = 0; r < 16; ++r) rli[r] = __builtin_amdgcn_rcpf(li_l[crow(r, hi)]);
    bf16_t* Ow = Ob + (long)(wid * 32) * ldo;
#pragma unroll
    for (int r = 0; r < 16; ++r) { const int orow = crow(r, hi);
#pragma unroll
        for (int d0 = 0; d0 < 4; ++d0) Ow[(long)orow * ldo + d0 * 32 + r32] = f2bf(o[d0][r] * rli[r]); }
    asm volatile("s_waitcnt vmcnt(0) lgkmcnt(0)" ::: "memory");
    __syncthreads();
#undef TROW
#undef LOADK
#undef LOADV
#undef WRITEK
#undef WRITEV
#undef VMW0
#undef ITER
#undef SCORES
#undef PSM
}

__device__ __forceinline__ void na_body(const bf16_t* __restrict__ QKV, int b, int rg, int h, const float* __restrict__ rpb_h, bf16_t* __restrict__ O, LAS char* lds, LAS float* tab) {
    constexpr int SHM = 16384, LD = 6144; constexpr float C = 0.088388347648318440f * LOG2E;
    int tid = threadIdx.x; asm volatile("" : "+v"(tid));
    const int wid = tid >> 6, lane = tid & 63, r32 = lane & 31, hi = lane >> 5;
    LAS char* V_lds = lds; LAS char* K_lds = lds + SHM;
    LAS float* ws = (LAS float*)(lds + 2 * SHM) + wid * 64; LAS float* li_l = ws; LAS float* al_l = ws + 32;
    for (int i = tid; i < 465; i += 512) tab[48 + i] = rpb_h[i] * LOG2E;
    const int qrow = 4 * rg + (wid >> 1), qc = (wid & 1) * 32 + r32;
    const int rs = min(max(qrow - 4, 0), 248), cs = min(max(qc - 8, 0), 48);
    const int R0 = min(max(4 * rg - 4, 0), 248), R1 = min(max(4 * rg - 1, 0), 248) + 8, nrt = R1 - R0, NT = nrt + 4;
    float m_reg = -1e30f, l_reg = 0; f32x16 o[4] = {}; bf16x8 qr[8];
    const bf16_t* Qw = QKV + ((long)b * SEQ + qrow * 64 + qc) * LD + h * 128 + hi * 8;
#pragma unroll
    for (int d0 = 0; d0 < 8; ++d0) qr[d0] = *(const bf16x8*)(Qw + d0 * 16);
    const bf16_t* Kh = QKV + 2048 + h * 128; const bf16_t* Vh = QKV + 4096 + h * 128;
    const int sr = tid >> 4, sc = (tid & 15) * 8, vst0 = v_st(sr, sc), vst1 = v_st(32 + sr, sc);
    const int kst0 = kswz<128>(sr, sc * 2), kst1 = kswz<128>(32 + sr, sc * 2);
    const int vb0 = (int)(unsigned)(uintptr_t)V_lds + v_rd_base(lane);
    bf16x8 vs0, vs1, ks0, ks1;
#define TROW(j) ((long)((j) < nrt ? b * SEQ + (R0 + (j)) * 64 : NLAT + b * CTXL + ((j) - nrt) * 64))
#define SLOAD(j) do { const long r0_ = TROW(j); vs0 = *(const bf16x8*)(&Vh[(r0_ + sr) * LD + sc]); vs1 = *(const bf16x8*)(&Vh[(r0_ + 32 + sr) * LD + sc]); \
    ks0 = *(const bf16x8*)(&Kh[(r0_ + sr) * LD + sc]); ks1 = *(const bf16x8*)(&Kh[(r0_ + 32 + sr) * LD + sc]); } while (0)
    SLOAD(0);
    for (int j = 0; j < NT; ++j) {
        asm volatile("s_waitcnt vmcnt(0)" ::: "memory");
        __syncthreads();
        *(LAS bf16x8*)(V_lds + vst0) = vs0; *(LAS bf16x8*)(V_lds + vst1) = vs1; *(LAS bf16x8*)(K_lds + kst0) = ks0; *(LAS bf16x8*)(K_lds + kst1) = ks1;
        __syncthreads();
        if (j + 1 < NT) SLOAD(j + 1);
        const bool isctx = j >= nrt; const int krow = R0 + j;
        if (isctx || (krow >= rs && krow < rs + 8)) {
            f32x16 p0, p1;
            qkt<128>(p0, p1, K_lds, qr, r32, hi);
            if (!isctx) {
                const int dr = krow - qrow + 7;
                const LAS float* tb = tab + 48 + dr * 31 + 15 - qc + 4 * hi;
#pragma unroll
                for (int r = 0; r < 16; ++r) { const int c0 = (r & 3) + 8 * (r >> 2); const int kc0 = c0 + 4 * hi, kc1 = kc0 + 32;
                    const float b0 = tb[c0], b1 = tb[c0 + 32];
                    p0[r] = (kc0 >= cs && kc0 < cs + 16) ? fmaf(p0[r], C, b0) : -1e30f;
                    p1[r] = (kc1 >= cs && kc1 < cs + 16) ? fmaf(p1[r], C, b1) : -1e30f; }
            } else {
#pragma unroll
                for (int r = 0; r < 16; ++r) { p0[r] *= C; p1[r] *= C; }
            }
            float pmax = p0[0];
#pragma unroll
            for (int r = 1; r < 16; ++r) pmax = fmaxf(pmax, p0[r]);
#pragma unroll
            for (int r = 0; r < 16; ++r) pmax = fmaxf(pmax, p1[r]);
            { auto rr = __builtin_amdgcn_permlane32_swap(__float_as_uint(pmax), __float_as_uint(pmax), false, false);
              pmax = fmaxf(__uint_as_float(rr[0]), __uint_as_float(rr[1])); }
            float mn, alpha;
            if (__all(pmax - m_reg <= THR * LOG2E)) { mn = m_reg; alpha = 1.f; }
            else { mn = fmaxf(m_reg, pmax); alpha = __builtin_amdgcn_exp2f(m_reg - mn); m_reg = mn; }
#pragma unroll
            for (int r = 0; r < 16; ++r) { p0[r] = __builtin_amdgcn_exp2f(p0[r] - mn); p1[r] = __builtin_amdgcn_exp2f(p1[r] - mn); }
            bf16x8 pa0, pa1, pa2, pa3;
            float ps = 0;
#pragma unroll
            for (int r = 0; r < 16; ++r) ps += p0[r] + p1[r];
            { auto rr = __builtin_amdgcn_permlane32_swap(__float_as_uint(ps), __float_as_uint(ps), false, false);
              ps = __uint_as_float(rr[0]) + __uint_as_float(rr[1]); }
            l_reg = l_reg * alpha + ps;
#define PK4(P, BASE, OUT) do { unsigned a0 = cvt_pk_bf16(P[BASE + 0], P[BASE + 1]), a1 = cvt_pk_bf16(P[BASE + 2], P[BASE + 3]);   \
    unsigned b0 = cvt_pk_bf16(P[BASE + 4], P[BASE + 5]), b1 = cvt_pk_bf16(P[BASE + 6], P[BASE + 7]);                              \
    auto r0 = __builtin_amdgcn_permlane32_swap(a0, b0, false, false); auto r1 = __builtin_amdgcn_permlane32_swap(a1, b1, false, false); \
    u32x4 w = {r0[0], r1[0], r0[1], r1[1]}; OUT = *reinterpret_cast<bf16x8*>(&w); } while (0)
            PK4(p0, 0, pa0); PK4(p0, 8, pa1); PK4(p1, 0, pa2); PK4(p1, 8, pa3);
#undef PK4
            RESC(alpha);
            pv_d0(o, vb0, pa0, pa1, pa2, pa3);
        }
    }
    if (hi == 0) li_l[r32] = l_reg; asm volatile("s_waitcnt lgkmcnt(0)" ::: "memory");
    float rli[16];
#pragma unroll
    for (int r = 0; r < 16; ++r) rli[r] = __builtin_amdgcn_rcpf(li_l[crow(r, hi)]);
    bf16_t* Ow = O + ((long)b * SEQ + qrow * 64 + (wid & 1) * 32) * DM + h * 128;
#pragma unroll
    for (int r = 0; r < 16; ++r) { const int orow = crow(r, hi);
#pragma unroll
        for (int d0 = 0; d0 < 4; ++d0) Ow[(long)orow * DM + d0 * 32 + r32] = f2bf(o[d0][r] * rli[r]); }
    asm volatile("s_waitcnt vmcnt(0) lgkmcnt(0)" ::: "memory");
    __syncthreads();
#undef TROW
#undef SLOAD
}
#undef RESC
}

#define XB_TMO      128
#define XB_XCNT(j)  (256  + 64 * (j))
#define XB_XSUB(j)  (1280 + 64 * (j))
#define XB_XGEN(j)  (2304 + 64 * (j))
#define XB_TOP      3328
#define XB_TOPGEN   3392
#define XCD_BAR_WORDS 3456
#define XB_SPIN_CAP (1u << 22)
__device__ __forceinline__ unsigned xb_ld(unsigned* p)              { return __hip_atomic_load(p, __ATOMIC_RELAXED, __HIP_MEMORY_SCOPE_AGENT); }
__device__ __forceinline__ unsigned xb_add(unsigned* p, unsigned v) { return __hip_atomic_fetch_add(p, v, __ATOMIC_RELAXED, __HIP_MEMORY_SCOPE_AGENT); }
__device__ __forceinline__ unsigned xb_xcc_id() { return (unsigned)__builtin_amdgcn_s_getreg((3 << 11) | 20) & 0xFu; }
#define XB_SPIN(cond, bar) do { unsigned _sp = 0; while (cond) { __builtin_amdgcn_s_sleep(1); \
    if ((++_sp & 255u) == 0u) { if (xb_ld(&(bar)[XB_TMO])) break; if (_sp > XB_SPIN_CAP) { atomicAdd(&(bar)[XB_TMO], 1u); break; } } } } while (0)
struct XcdBarrier { unsigned* bar; unsigned x; volatile LAS unsigned* st; };
__device__ __forceinline__ XcdBarrier xcd_barrier_post(unsigned* bar, volatile LAS unsigned* st) {
    XcdBarrier b; b.bar = bar; b.x = xb_xcc_id(); b.st = st;
    if (threadIdx.x == 0) (void)xb_add(&bar[XB_XCNT(b.x)], 1u);
    return b;
}
__device__ __forceinline__ void xcd_barrier_complete(unsigned* bar, unsigned x, unsigned& nloc, unsigned& nx) {
    const unsigned G = gridDim.x * gridDim.y * gridDim.z;
    unsigned sum, cnt, mine, sp = 0u;
    for (;;) {
        sum = 0u; cnt = 0u; mine = 0u;
#pragma unroll
        for (unsigned j = 0; j < 16; ++j) { const unsigned c = xb_ld(&bar[XB_XCNT(j)]); sum += c; cnt += (c > 0u) ? 1u : 0u; mine = (j == x) ? c : mine; }
        if (sum == G) break;
        __builtin_amdgcn_s_sleep(1);
        if ((++sp & 255u) == 0u) { if (xb_ld(&bar[XB_TMO])) break; if (sp > XB_SPIN_CAP) { atomicAdd(&bar[XB_TMO], 1u); break; } }
    }
    nloc = mine > 0u ? mine : 1u; nx = cnt > 0u ? cnt : 1u;
}
__device__ __forceinline__ void xcd_barrier(const XcdBarrier& b) {
    asm volatile("s_waitcnt vmcnt(0)" ::: "memory");
    __syncthreads();
    if (threadIdx.x == 0) {
        unsigned* bar = b.bar;
        __builtin_amdgcn_s_waitcnt(0);
        unsigned nloc = b.st[0], nx = b.st[1];
        if (nloc == 0u) { xcd_barrier_complete(bar, b.x, nloc, nx); b.st[0] = nloc; b.st[1] = nx; }
        const unsigned old = xb_add(&bar[XB_XSUB(b.x)], 1u);
        const unsigned gen = old / nloc;
        if (old + 1u == (gen + 1u) * nloc) {
            __builtin_amdgcn_fence(__ATOMIC_RELEASE, "agent");
            asm volatile("s_waitcnt vmcnt(0)" ::: "memory");
            const unsigned og = xb_add(&bar[XB_TOP], 1u);
            const unsigned tg = og / nx;
            if (og + 1u == (tg + 1u) * nx) xb_add(&bar[XB_TOPGEN], 1u);
            else XB_SPIN(xb_ld(&bar[XB_TOPGEN]) == tg, bar);
            __builtin_amdgcn_fence(__ATOMIC_ACQUIRE, "agent");
            xb_add(&bar[XB_XGEN(b.x)], 1u);
            asm volatile("s_waitcnt vmcnt(0)" ::: "memory");
        } else {
            XB_SPIN(xb_ld(&bar[XB_XGEN(b.x)]) == gen, bar);
            __builtin_amdgcn_fence(__ATOMIC_ACQUIRE, "agent");
            asm volatile("s_waitcnt vmcnt(0)" ::: "memory");
        }
    }
    __syncthreads();
}

constexpr int NIN = 27;
struct Args { const float* in[NIN]; float* out; unsigned char* ws; int ph_lo, ph_hi; unsigned rep_mask, pad; };
struct Frame {
    LAS unsigned char* lds; int tid, lane, wave, vcu, G, gw, NGW;
    unsigned char* ws; float* X; bf16_t* H; bf16_t* O; unsigned char* big; unsigned char* wts; float* mods; float* tab; float* rs;
};
constexpr int PPL = 11;
constexpr int NPH = 1 + DEPTH * PPL + 1;
__host__ __device__ inline bool phase_exists(int ph) {
    if (ph == 0 || ph == NPH - 1) return true;
    const int l = (ph - 1) / PPL, j = (ph - 1) % PPL, kind = l % 3;
    if (j == 2) return kind != 0;
    if (j == 3 || j == 4) return kind == 1;
    return true;
}

__device__ __forceinline__ void transpose_item(const float* W, int K, int N, bf16_t* WT, int mode, int row_off, const float* ks, LAS float* scr, int item, int lane) {
    const int nblk = N / 32, kb = item / nblk, nb = item % nblk, k0 = 64 * kb, n0 = 32 * nb;
#pragma unroll 8
    for (int i = 0; i < 32; ++i) { const int kk = 2 * i + (lane >> 5); float v = W[(size_t)(k0 + kk) * N + n0 + (lane & 31)]; if (ks) v *= ks[k0 + kk]; scr[kk * 33 + (lane & 31)] = v; }
    asm volatile("s_waitcnt lgkmcnt(0)" ::: "memory");
    const int c = lane & 7;
#pragma unroll
    for (int j = 0; j < 4; ++j) { const int n = (lane >> 3) + 8 * j; const LAS float* s = scr + (8 * c) * 33 + n;
        u32x4 o; o.x = cvt_pk_bf16(s[0 * 33], s[1 * 33]); o.y = cvt_pk_bf16(s[2 * 33], s[3 * 33]); o.z = cvt_pk_bf16(s[4 * 33], s[5 * 33]); o.w = cvt_pk_bf16(s[6 * 33], s[7 * 33]);
        const int nn = n0 + n; int drow;
        if (mode == 1) { if (nn < FFD) drow = (nn >> 7) * 256 + (nn & 127); else { const int ch = nn - FFD; drow = (ch >> 7) * 256 + 128 + (ch & 127); } }
        else drow = row_off + nn;
        *(u32x4*)(WT + (size_t)drow * K + k0 + 8 * c) = o; }
    asm volatile("s_waitcnt lgkmcnt(0)" ::: "memory");
}

typedef const __attribute__((address_space(4))) Args* KArgs;
__device__ __forceinline__ void prologue_phase(Frame& F, KArgs a) {
    LAS float* sil = (LAS float*)F.lds;
    for (int i = F.tid; i < 3 * DM; i += 512) { const int j = i / DM, k = i % DM; const float c = (j < 2) ? a->in[1][j * DM + k] : a->in[3][k]; sil[i] = silu_f(c); }
    __syncthreads();
    for (int task = F.gw; task < DEPTH * (MODW / 32); task += F.NGW) {
        const int l = task / (MODW / 32), n0 = (task % (MODW / 32)) * 32, col = n0 + (F.lane & 31), kp = F.lane >> 5;
        const float* w = a->in[4] + (size_t)l * DM * MODW + col;
        float a0 = 0.f, a1 = 0.f, a2 = 0.f;
#pragma unroll 8
        for (int k = kp; k < DM; k += 2) { const float wv = w[(size_t)k * MODW]; a0 = fmaf(sil[k], wv, a0); a1 = fmaf(sil[DM + k], wv, a1); a2 = fmaf(sil[2 * DM + k], wv, a2); }
        a0 += __shfl_xor(a0, 32); a1 += __shfl_xor(a1, 32); a2 += __shfl_xor(a2, 32);
        if (kp == 0) { const float bv = a->in[5][l * MODW + col]; float* m = F.mods + (size_t)l * 3 * MODW + col; m[0] = a0 + bv; m[MODW] = a1 + bv; m[2 * MODW] = a2 + bv; }
    }
    if (blockIdx.x == 0) {
        for (int i = F.tid; i < 256 * 16 + 256 * 32; i += 512) {
            int pos, ii, quarter; float* cdst; float* sdst;
            if (i < 256 * 16) { pos = i / 16; ii = i % 16; quarter = 16; cdst = F.tab + i; sdst = F.tab + 4096 + i; }
            else { const int k = i - 256 * 16; pos = k / 32; ii = k % 32; quarter = 32; cdst = F.tab + 8192 + k; sdst = F.tab + 16384 + k; }
            const float inv = exp2f(-13.287712379549449f * (float)ii / (float)quarter);
            const float ang = (float)pos * inv;
            const double rev = (double)ang * 0.15915494309189535; const double fr = rev - floor(rev);
            *cdst = __builtin_amdgcn_cosf((float)fr); *sdst = __builtin_amdgcn_sinf((float)fr);
        }
    }
    LAS float* scr = (LAS float*)(F.lds + 32768 + F.wave * 8704);
    {
        constexpr int I_UP = (DM / 64) * (2 * FFD / 32), I_DN = (FFD / 64) * (DM / 32), I_NQ = (DM / 64) * (3 * DM / 32), I_NO = (DM / 64) * (DM / 32);
        constexpr int I_MQA = (DM / 64) * (512 / 32), I_MKA = (DM / 64) * (576 / 32), I_MQB = (512 / 64) * (3072 / 32), I_MKB = (512 / 64) * (4096 / 32), I_MO = I_NO;
        constexpr int I_GQ = (DM / 64) * (3072 / 32), I_GO = I_NO;
        constexpr int NITEMS = 4 * I_UP + 4 * I_DN + 2 * I_NQ + 2 * I_NO + I_MQA + I_MKA + I_MQB + I_MKB + I_MO + I_GQ + I_GO;
        bf16_t* wt = (bf16_t*)F.wts;
        for (int it = F.gw; it < NITEMS; it += F.NGW) {
            int r = it;
            if (r < 4 * I_UP) { const int l = r / I_UP; transpose_item(a->in[8] + (size_t)l * DM * 2 * FFD, DM, 2 * FFD, (bf16_t*)(F.wts + W_UP + l * W_UP_L), 1, 0, nullptr, scr, r % I_UP, F.lane); continue; } r -= 4 * I_UP;
            if (r < 4 * I_DN) { const int l = r / I_DN; transpose_item(a->in[11] + (size_t)l * FFD * DM, FFD, DM, (bf16_t*)(F.wts + W_DN + l * W_DN_L), 0, 0, nullptr, scr, r % I_DN, F.lane); continue; } r -= 4 * I_DN;
            if (r < 2 * I_NQ) { const int l = r / I_NQ; transpose_item(a->in[12] + (size_t)l * DM * 3 * DM, DM, 3 * DM, (bf16_t*)(F.wts + W_NAQKV + l * W_NAQKV_L), 0, 0, nullptr, scr, r % I_NQ, F.lane); continue; } r -= 2 * I_NQ;
            if (r < 2 * I_NO) { const int l = r / I_NO; transpose_item(a->in[14] + (size_t)l * DM * DM, DM, DM, (bf16_t*)(F.wts + W_NAWO + l * W_NAWO_L), 0, 0, nullptr, scr, r % I_NO, F.lane); continue; } r -= 2 * I_NO;
            if (r < I_MQA) { transpose_item(a->in[15], DM, 512, (bf16_t*)(F.wts + W_MLA1), 0, 0, nullptr, scr, r, F.lane); continue; } r -= I_MQA;
            if (r < I_MKA) { transpose_item(a->in[18], DM, 576, (bf16_t*)(F.wts + W_MLA1), 0, 512, nullptr, scr, r, F.lane); continue; } r -= I_MKA;
            if (r < I_MQB) { transpose_item(a->in[17], 512, 3072, (bf16_t*)(F.wts + W_MLAQB), 0, 0, a->in[16], scr, r, F.lane); continue; } r -= I_MQB;
            if (r < I_MKB) { transpose_item(a->in[20], 512, 4096, (bf16_t*)(F.wts + W_MLAKVB), 0, 0, a->in[19], scr, r, F.lane); continue; } r -= I_MKB;
            if (r < I_MO) { transpose_item(a->in[21], DM, DM, (bf16_t*)(F.wts + W_MLAWO), 0, 0, nullptr, scr, r, F.lane); continue; } r -= I_MO;
            if (r < I_GQ) { transpose_item(a->in[22], DM, 3072, (bf16_t*)(F.wts + W_GQAQKV), 0, 0, nullptr, scr, r, F.lane); continue; } r -= I_GQ;
            transpose_item(a->in[25], DM, DM, (bf16_t*)(F.wts + W_GQAWO), 0, 0, nullptr, scr, r, F.lane);
        }
        (void)wt;
        u32x4* z = (u32x4*)(F.wts + W_MLA1 + (size_t)1088 * DM * 2);
        const u32x4 zero = {0u, 0u, 0u, 0u};
        for (int i = blockIdx.x * 512 + F.tid; i < 192 * DM * 2 / 16; i += F.G * 512) z[i] = zero;
    }
    {
        const f32x4* xs = (const f32x4*)a->in[0]; const f32x4* cs = (const f32x4*)a->in[2]; f32x4* xd = (f32x4*)F.X;
        const size_t n1 = (size_t)NLAT * DM / 4, n2 = (size_t)NBATCH * CTXL * DM / 4;
        for (size_t i = (size_t)blockIdx.x * 512 + F.tid; i < n1 + n2; i += (size_t)F.G * 512) xd[i] = i < n1 ? xs[i] : cs[i - n1];
    }
}

__device__ __forceinline__ void norm_phase(Frame& F, const float* gain, const float* mods_l, int sh_off, int sc_off, int nrows, const float* pgate, int pks) {
    for (int row = F.gw; row < nrows; row += F.NGW) {
        const float* m = mods_l + (size_t)row_midx(row) * MODW;
        f32x4* xr = (f32x4*)(F.X + (size_t)row * DM) + F.lane;
        f32x4 v[8]; float s = 0.f;
#pragma unroll
        for (int j = 0; j < 8; ++j) v[j] = xr[64 * j];
        if (pgate != nullptr && row >= NLAT) {
            const f32x4* pr = (const f32x4*)((const float*)(F.ws + WS_PART) + (size_t)(row - NLAT) * DM) + F.lane;
            f32x4 a[8];
#pragma unroll
            for (int j = 0; j < 8; ++j) a[j] = (f32x4){0.f, 0.f, 0.f, 0.f};
            for (int kc = 0; kc < pks; ++kc) {
#pragma unroll
                for (int j = 0; j < 8; ++j) a[j] += pr[(size_t)kc * (NBATCH * CTXL) * (DM / 4) + 64 * j];
            }
#pragma unroll
            for (int j = 0; j < 8; ++j) { v[j] += *(const f32x4*)(pgate + (F.lane + 64 * j) * 4) * a[j]; xr[64 * j] = v[j]; }
        }
#pragma unroll
        for (int j = 0; j < 8; ++j) s += (v[j].x * v[j].x + v[j].y * v[j].y) + (v[j].z * v[j].z + v[j].w * v[j].w);
        const float rstd = rsqrtf(wave_sum(s) * (1.f / DM) + NORM_EPS);
        u32x2* o8 = (u32x2*)(F.H + (size_t)row * DM) + F.lane;
#pragma unroll
        for (int j = 0; j < 8; ++j) { const int col = (F.lane + 64 * j) * 4;
            const f32x4 g = *(const f32x4*)(gain + col), sc = *(const f32x4*)(m + sc_off + col), sh = *(const f32x4*)(m + sh_off + col);
            const f32x4 y = (v[j] * rstd) * g * (sc + 1.0f) + sh;
            u32x2 w; w.x = cvt_pk_bf16(y.x, y.y); w.y = cvt_pk_bf16(y.z, y.w); o8[64 * j] = w; }
    }
}
__device__ __forceinline__ void final_phase(Frame& F, const float* gain, float* out) {
    for (int row = F.gw; row < NLAT; row += F.NGW) {
        const f32x4* xr = (const f32x4*)(F.X + (size_t)row * DM) + F.lane;
        f32x4 v[8]; float s = 0.f;
#pragma unroll
        for (int j = 0; j < 8; ++j) { v[j] = xr[64 * j]; s += (v[j].x * v[j].x + v[j].y * v[j].y) + (v[j].z * v[j].z + v[j].w * v[j].w); }
        const float rstd = rsqrtf(wave_sum(s) * (1.f / DM) + NORM_EPS);
        f32x4* o = (f32x4*)(out + (size_t)row * DM) + F.lane;
#pragma unroll
        for (int j = 0; j < 8; ++j) { const int col = (F.lane + 64 * j) * 4; o[64 * j] = (v[j] * rstd) * *(const f32x4*)(gain + col); }
    }
}
__device__ __forceinline__ void mla_post1_phase(Frame& F) {
    const bf16_t* T1 = (const bf16_t*)(F.big + BIG_T1); bf16_t* KPE = (bf16_t*)(F.big + BIG_KPE);
    const float* tc = F.tab; const float* ts = F.tab + 4096;
    for (int row = F.gw; row < MROWS; row += F.NGW) {
        const bf16_t* t = T1 + (size_t)row * 1280;
        const u32x4 qa = *(const u32x4*)(t + F.lane * 8), ka = *(const u32x4*)(t + 512 + F.lane * 8);
        float sa = 0.f, sb = 0.f;
#pragma unroll
        for (int j = 0; j < 4; ++j) { const float a0 = bf_lo(qa[j]), a1 = bf_hi(qa[j]), b0 = bf_lo(ka[j]), b1 = bf_hi(ka[j]); sa += a0 * a0 + a1 * a1; sb += b0 * b0 + b1 * b1; }
        sa = wave_sum(sa); sb = wave_sum(sb);
        if (F.lane == 0) { F.rs[(size_t)row * 2] = rsqrtf(sa * (1.f / 512.f) + NORM_EPS); F.rs[(size_t)row * 2 + 1] = rsqrtf(sb * (1.f / 512.f) + NORM_EPS); }
        float x = bf2f(t[1024 + F.lane]);
        const float xp = __shfl_xor(x, 16);
        if (row < NLAT) { const int tok = row & (SEQ - 1); const int pos = (F.lane < 32) ? (tok >> 6) : (tok & 63); const int ii = F.lane & 15;
            const float c = tc[pos * 16 + ii], s = ts[pos * 16 + ii]; x = (F.lane & 16) ? (x * c + xp * s) : (x * c - xp * s); }
        KPE[(size_t)row * 64 + F.lane] = f2bf(x);
    }
}
__device__ __forceinline__ void mla_qrope_phase(Frame& F) {
    bf16_t* Q = (bf16_t*)(F.big + BIG_Q); const float* tc = F.tab; const float* ts = F.tab + 4096;
    for (int row = F.gw; row < NLAT; row += F.NGW) {
        const int tok = row & (SEQ - 1), e4 = (F.lane & 15) * 4, q = e4 >> 4, pos = (q < 2) ? (tok >> 6) : (tok & 63), ii = e4 & 15;
        const f32x4 c = *(const f32x4*)(tc + pos * 16 + ii), s = *(const f32x4*)(ts + pos * 16 + ii);
        const float sg = (q & 1) ? 1.f : -1.f;
        u32x2 w[4];
#pragma unroll
        for (int it = 0; it < 4; ++it) w[it] = *(const u32x2*)(Q + (size_t)row * 3072 + (4 * it + (F.lane >> 4)) * 192 + 128 + e4);
#pragma unroll
        for (int it = 0; it < 4; ++it) {
            u32x2 p; p.x = __shfl_xor(w[it].x, 4); p.y = __shfl_xor(w[it].y, 4);
            const float x0 = bf_lo(w[it].x), x1 = bf_hi(w[it].x), x2 = bf_lo(w[it].y), x3 = bf_hi(w[it].y);
            const float y0 = bf_lo(p.x), y1 = bf_hi(p.x), y2 = bf_lo(p.y), y3 = bf_hi(p.y);
            u32x2 o; o.x = cvt_pk_bf16(x0 * c.x + sg * y0 * s.x, x1 * c.y + sg * y1 * s.y); o.y = cvt_pk_bf16(x2 * c.z + sg * y2 * s.z, x3 * c.w + sg * y3 * s.w);
            *(u32x2*)(Q + (size_t)row * 3072 + (4 * it + (F.lane >> 4)) * 192 + 128 + e4) = o;
        }
    }
}
__device__ __forceinline__ void gqa_post_phase(Frame& F, const float* qn, const float* kn) {
    bf16_t* QKV = (bf16_t*)(F.big + BIG_QKV); const float* tc = F.tab + 8192; const float* ts = F.tab + 16384;
    for (int row = F.gw; row < MROWS; row += F.NGW) {
        const bool lat = row < NLAT; const int tok = row & (SEQ - 1), e4 = (F.lane & 31) * 4, q = e4 >> 5, pos = (q < 2) ? (tok >> 6) : (tok & 63), ii = e4 & 31;
        f32x4 c = {1.f, 1.f, 1.f, 1.f}, s = {0.f, 0.f, 0.f, 0.f};
        if (lat) { c = *(const f32x4*)(tc + pos * 32 + ii); s = *(const f32x4*)(ts + pos * 32 + ii); }
        const float sg = (q & 1) ? 1.f : -1.f;
        const f32x4 gq = *(const f32x4*)(qn + e4), gk = *(const f32x4*)(kn + e4);
#pragma unroll 2
        for (int it = 0; it < 10; ++it) {
            const int hh = 2 * it + (F.lane >> 5);
            bf16_t* p = QKV + (size_t)row * 3072 + hh * 128 + e4;
            const u32x2 w = *(const u32x2*)p;
            float x0 = bf_lo(w.x), x1 = bf_hi(w.x), x2 = bf_lo(w.y), x3 = bf_hi(w.y);
            float ss = x0 * x0 + x1 * x1 + x2 * x2 + x3 * x3;
#pragma unroll
            for (int o = 1; o < 32; o <<= 1) ss += __shfl_xor(ss, o);
            const float rstd = rsqrtf(ss * (1.f / 128.f) + NORM_EPS);
            const f32x4 g = (hh < 16) ? gq : gk;
            x0 = x0 * rstd * g.x; x1 = x1 * rstd * g.y; x2 = x2 * rstd * g.z; x3 = x3 * rstd * g.w;
            const float y0 = __shfl_xor(x0, 8), y1 = __shfl_xor(x1, 8), y2 = __shfl_xor(x2, 8), y3 = __shfl_xor(x3, 8);
            const float qs = (hh < 16) ? (0.088388347648318440f * LOG2E) : 1.0f;
            u32x2 o; o.x = cvt_pk_bf16((x0 * c.x + sg * y0 * s.x) * qs, (x1 * c.y + sg * y1 * s.y) * qs); o.y = cvt_pk_bf16((x2 * c.z + sg * y2 * s.z) * qs, (x3 * c.w + sg * y3 * s.w) * qs);
            *(u32x2*)p = o;
        }
    }
}
__device__ __forceinline__ void ffn_fix_phase(Frame& F, const float* cw, const float* cb, int nblk) {
    bf16_t* ACT = (bf16_t*)(F.big + BIG_ACT); const float* side = (const float*)(F.big + BIG_SIDE);
    const int total = nblk * 2 * (FFD / 4);
    for (int idx = blockIdx.x * 512 + F.tid; idx < total; idx += F.G * 512) {
        const int c4 = idx % (FFD / 4), t = idx / (FFD / 4), which = t & 1, blk = t >> 1, ch = c4 * 4;
        const f32x4 w0 = *(const f32x4*)(cw + ch), w1 = *(const f32x4*)(cw + FFD + ch), w2 = *(const f32x4*)(cw + 2 * FFD + ch), bb = *(const f32x4*)(cb + ch);
        const float* sb = side + (size_t)blk * FFD + ch;
        f32x4 prev, g0, nx, v; int row;
        if (which == 0) { row = blk * 64; const bool st = (row == 0 || row == SEQ || row == NLAT || row == NLAT + CTXL);
            prev = st ? (f32x4){0.f, 0.f, 0.f, 0.f} : *(const f32x4*)(sb - FFD + 3 * SIDE_ARR); g0 = *(const f32x4*)(sb + 0 * SIDE_ARR); nx = *(const f32x4*)(sb + 1 * SIDE_ARR); v = *(const f32x4*)(sb + 4 * SIDE_ARR); }
        else { row = blk * 64 + 63; const bool en = (row == SEQ - 1 || row == NLAT - 1 || row == NLAT + CTXL - 1 || row == MROWS - 1);
            prev = *(const f32x4*)(sb + 2 * SIDE_ARR); g0 = *(const f32x4*)(sb + 3 * SIDE_ARR); nx = en ? (f32x4){0.f, 0.f, 0.f, 0.f} : *(const f32x4*)(sb + FFD + 0 * SIDE_ARR); v = *(const f32x4*)(sb + 5 * SIDE_ARR); }
        const f32x4 c = bb + w0 * prev + w1 * g0 + w2 * nx;
        u32x2 o; o.x = cvt_pk_bf16(silu_f(c.x) * v.x, silu_f(c.y) * v.y); o.y = cvt_pk_bf16(silu_f(c.z) * v.z, silu_f(c.w) * v.w);
        *(u32x2*)(ACT + (size_t)row * FFD + ch) = o;
    }
}

template <int DK, int SD, int QL, bool PS, int PF>
__device__ __forceinline__ void dense_attn_phase(Frame& F, const bf16_t* Q, int ldq, int qhs, const bf16_t* K, int ldk, int khs, int kdiv, const bf16_t* KP, const bf16_t* V, int ldv, bool need_ctx) {
    const int nunits = 2048 + (need_ctx ? 32 : 0);
    for (int u = F.vcu; u < nunits; u += F.G) {
        int b, h, qrow0, base0, n0, base1, NT;
        if (u < 2048) { b = u >> 10; h = (u >> 6) & 15; const int qb = u & 63; qrow0 = b * SEQ + qb * 256; base0 = b * SEQ; n0 = 256; base1 = NLAT + b * CTXL; NT = 260; }
        else { const int uc = u - 2048; b = uc >> 4; h = uc & 15; qrow0 = NLAT + b * CTXL; base0 = 0; n0 = 0; base1 = NLAT + b * CTXL; NT = 4; }
        const int kh = h / kdiv;
        att::dense_body<DK, SD, QL, PS, PF>(Q + (size_t)qrow0 * ldq + h * qhs, ldq, K + kh * khs, ldk, KP, V + kh * khs, ldv, F.O + (size_t)qrow0 * DM + h * 128, DM, base0, n0, base1, NT, (LAS char*)F.lds);
    }
}
__device__ __forceinline__ void na_attn_phase(Frame& F, const float* rpb, bool need_ctx) {
    const bf16_t* QKV = (const bf16_t*)(F.big + BIG_QKV);
    LAS float* tab = (LAS float*)(F.lds + NATAB_OFF);
    for (int u = F.vcu; u < 2048; u += F.G) {
        const int b = u >> 10, h = (u >> 6) & 15, rg = u & 63;
        att::na_body(QKV, b, rg, h, rpb + h * 465, F.O, (LAS char*)F.lds, tab);
    }
    if (need_ctx) {
        for (int uc = F.vcu; uc < 32; uc += F.G) {
            const int b = uc >> 4, h = uc & 15, qrow0 = NLAT + b * CTXL;
            att::dense_body<128, 1, 0, false, 1>(QKV + (size_t)qrow0 * 6144 + h * 128, 6144, QKV + 2048 + h * 128, 6144, nullptr, QKV + 4096 + h * 128, 6144, F.O + (size_t)qrow0 * DM + h * 128, DM, 0, 0, qrow0, 4, (LAS char*)F.lds);
        }
    }
}

__global__ void __launch_bounds__(512, 2) mega_fwd(Args args) {
    extern __shared__ __attribute__((aligned(16))) unsigned char lds[];
    Frame F;
    F.lds = (LAS unsigned char*)lds;
    F.tid = threadIdx.x; F.lane = F.tid & 63; F.wave = __builtin_amdgcn_readfirstlane(F.tid >> 6);
    F.G = gridDim.x; { const int bx = blockIdx.x; F.vcu = (F.G % 8 == 0) ? (bx % 8) * (F.G / 8) + bx / 8 : bx; }
    F.gw = F.vcu * 8 + F.wave; F.NGW = F.G * 8;
    const KArgs kargs = (KArgs)__builtin_amdgcn_kernarg_segment_ptr();
#define PH_BEGIN KArgs ap = kargs; asm volatile("" : "+s"(ap)); { int t_ = threadIdx.x; asm volatile("" : "+v"(t_)); F.tid = t_; F.lane = t_ & 63; } { unsigned char* ws_ = ap->ws; F.ws = ws_; F.X = (float*)(ws_ + WS_X); F.H = (bf16_t*)(ws_ + WS_H); F.O = (bf16_t*)(ws_ + WS_O); \
        F.big = ws_ + WS_BIG; F.wts = ws_ + WS_W; F.mods = (float*)(ws_ + WS_MODS); F.tab = (float*)(ws_ + WS_TAB); F.rs = (float*)(ws_ + WS_RS); } \
        const float* mods_l = F.mods + (size_t)layer * 3 * MODW; (void)mods_l
    volatile LAS unsigned* MISC = (volatile LAS unsigned*)(F.lds + MISC_OFF);
    for (int u = F.tid; u < (LDS_BYTES - LDSCTL_OFF) / 4; u += 512) ((LAS unsigned*)(F.lds + LDSCTL_OFF))[u] = 0u;
    __syncthreads();
    const int lo = kargs->ph_lo, hi = kargs->ph_hi;
    unsigned* barw = (unsigned*)(kargs->ws + WS_CTL) + CW_BAR;
    XcdBarrier bar; bar.bar = barw; bar.x = 0; bar.st = nullptr;
    if (hi - lo > 1) bar = xcd_barrier_post(barw, MISC + 8);
#define IN(k) (lo <= (k) && (k) < hi)
#define SEAM(k) do { if ((k) + 1 < hi) xcd_barrier(bar); } while (0)

    if (EN(0) && IN(0)) { const int layer = 0; PH_BEGIN; _Pragma("nounroll") for (int rp_ = 0; rp_ < RPT(0); ++rp_) prologue_phase(F, ap); SEAM(0); }

    for (int layer = 0; layer < DEPTH; ++layer) {
        const int kind = layer % 3, jm = layer / 3, pb = 1 + layer * PPL;
        const bool last = (layer == DEPTH - 1);
        const int mrows = last ? NLAT : MROWS;
        if (EN(1) && IN(pb + 0)) { PH_BEGIN; _Pragma("nounroll") for (int rp_ = 0; rp_ < RPT(1); ++rp_) norm_phase(F, ap->in[6] + layer * DM, mods_l, 0, DM, MROWS, layer > 0 ? mods_l - 3 * MODW + 5 * DM + 2 * MODW : nullptr, DN_KS); SEAM(pb + 0); }
        if (IN(pb + 1)) {
            PH_BEGIN; pg8::StaticOrder S;
            if (EN(2) && kind == 0) { pg8::Gemm g{F.H, (const bf16_t*)(F.wts + W_NAQKV + jm * W_NAQKV_L), MROWS, 6144, DM, DM}; S.init(MROWS, 6144, DM, F.G, (int)blockIdx.x);
                pg8::EpiBf16<false> E{(bf16_t*)(F.big + BIG_QKV), 6144, nullptr, 0, 1.0f}; pg8::gemm_phase(F.lds, g, S, E); }
            else if (EN(3) && kind == 1) { pg8::Gemm g{F.H, (const bf16_t*)(F.wts + W_MLA1), MROWS, 1280, DM, DM}; S.init(MROWS, 1280, DM, F.G, (int)blockIdx.x);
                pg8::EpiBf16<false> E{(bf16_t*)(F.big + BIG_T1), 1280, nullptr, 0, 1.0f}; pg8::gemm_phase(F.lds, g, S, E); }
            else if (EN(4) && kind == 2) { pg8::Gemm g{F.H, (const bf16_t*)(F.wts + W_GQAQKV), MROWS, 3072, DM, DM}; S.init(MROWS, 3072, DM, F.G, (int)blockIdx.x);
                pg8::EpiBf16<false> E{(bf16_t*)(F.big + BIG_QKV), 3072, nullptr, 0, 1.0f}; pg8::gemm_phase(F.lds, g, S, E); }
            SEAM(pb + 1);
        }
        if (kind != 0 && IN(pb + 2)) {
            PH_BEGIN;
            _Pragma("nounroll") for (int rp_ = 0; rp_ < RPT(5); ++rp_) { if (EN(5) && kind == 1) mla_post1_phase(F); else if (EN(6) && kind == 2) { if (rp_ == 0) gqa_post_phase(F, ap->in[23], ap->in[24]); } }
            SEAM(pb + 2);
        }
        if (EN(7) && kind == 1 && IN(pb + 3)) {
            PH_BEGIN;
            { pg8::StaticOrder S; pg8::Gemm g{(const bf16_t*)(F.big + BIG_T1), (const bf16_t*)(F.wts + W_MLAQB), MROWS, 3072, 512, 1280}; S.init(MROWS, 3072, 512, F.G, (int)blockIdx.x);
              pg8::EpiBf16<true> E{(bf16_t*)(F.big + BIG_Q), 3072, F.rs, 0, 0.072168783648703220f * LOG2E}; pg8::gemm_phase(F.lds, g, S, E); }
            { pg8::StaticOrder S; pg8::Gemm g{(const bf16_t*)(F.big + BIG_T1) + 512, (const bf16_t*)(F.wts + W_MLAKVB), MROWS, 4096, 512, 1280}; S.init(MROWS, 4096, 512, F.G, (int)blockIdx.x);
              pg8::EpiBf16<true> E{(bf16_t*)(F.big + BIG_KV), 4096, F.rs, 1, 1.0f}; pg8::gemm_phase(F.lds, g, S, E); }
            SEAM(pb + 3);
        }
        if (EN(8) && kind == 1 && IN(pb + 4)) { PH_BEGIN; mla_qrope_phase(F); SEAM(pb + 4); }
        if (IN(pb + 5)) {
            PH_BEGIN;
            if (EN(9) && kind == 0) _Pragma("nounroll") for (int rp_ = 0; rp_ < RPT(9); ++rp_) na_attn_phase(F, ap->in[13] + (size_t)jm * 16 * 465, !last);
            else if (EN(10) && kind == 1) { const bf16_t* KV = (const bf16_t*)(F.big + BIG_KV); _Pragma("nounroll") for (int rp_ = 0; rp_ < RPT(10); ++rp_)
                dense_attn_phase<192, 1, 6, true, 1>(F, (const bf16_t*)(F.big + BIG_Q), 3072, 192, KV, 4096, 256, 1, (const bf16_t*)(F.big + BIG_KPE), KV + 128, 4096, !last); }
            else if (EN(11) && kind == 2) { const bf16_t* QKV = (const bf16_t*)(F.big + BIG_QKV); _Pragma("nounroll") for (int rp_ = 0; rp_ < RPT(11); ++rp_)
                dense_attn_phase<128, 1, 0, true, 3>(F, QKV, 3072, 128, QKV + 2048, 3072, 128, 4, nullptr, QKV + 2560, 3072, !last); }
            SEAM(pb + 5);
        }
        if (EN(12) && IN(pb + 6)) {
            PH_BEGIN;
            const bf16_t* wo = (const bf16_t*)(F.wts + (kind == 0 ? W_NAWO + jm * W_NAWO_L : (kind == 1 ? W_MLAWO : W_GQAWO)));
            pg8::StaticOrder S; pg8::Gemm g{F.O, wo, mrows, DM, DM, DM}; S.init(NLAT, DM, DM, F.G, (int)blockIdx.x, mrows - NLAT, WO_KS);
            pg8::EpiResid E{F.X, mods_l + 2 * DM, (float*)(F.ws + WS_PART)}; pg8::gemm_phase(F.lds, g, S, E);
            SEAM(pb + 6);
        }
        if (EN(1) && IN(pb + 7)) { PH_BEGIN; _Pragma("nounroll") for (int rp_ = 0; rp_ < RPT(1); ++rp_) norm_phase(F, ap->in[7] + layer * DM, mods_l, 3 * DM, 4 * DM, mrows, last ? nullptr : mods_l + 2 * DM + 2 * MODW, WO_KS); SEAM(pb + 7); }
        if (EN(13) && IN(pb + 8)) {
            PH_BEGIN;
            pg8::StaticOrder S; pg8::Gemm g{F.H, (const bf16_t*)(F.wts + W_UP + layer * W_UP_L), mrows, 2 * FFD, DM, DM}; S.init(mrows, 2 * FFD, DM, F.G, (int)blockIdx.x);
            pg8::EpiGlu E{(bf16_t*)(F.big + BIG_ACT), ap->in[9] + (size_t)layer * 3 * FFD, ap->in[10] + (size_t)layer * FFD, (float*)(F.big + BIG_SIDE)}; _Pragma("nounroll") for (int rp_ = 0; rp_ < RPT(13); ++rp_) pg8::gemm_phase(F.lds, g, S, E);
            SEAM(pb + 8);
        }
        if (EN(14) && IN(pb + 9)) { PH_BEGIN; _Pragma("nounroll") for (int rp_ = 0; rp_ < RPT(14); ++rp_) ffn_fix_phase(F, ap->in[9] + (size_t)layer * 3 * FFD, ap->in[10] + (size_t)layer * FFD, mrows / 64); SEAM(pb + 9); }
        if (EN(15) && IN(pb + 10)) {
            PH_BEGIN;
            pg8::StaticOrder S; pg8::Gemm g{(const bf16_t*)(F.big + BIG_ACT), (const bf16_t*)(F.wts + W_DN + layer * W_DN_L), mrows, DM, FFD, FFD}; S.init(NLAT, DM, FFD, F.G, (int)blockIdx.x, mrows - NLAT, DN_KS);
            pg8::EpiResid E{F.X, mods_l + 5 * DM, (float*)(F.ws + WS_PART)}; pg8::gemm_phase(F.lds, g, S, E);
            SEAM(pb + 10);
        }
    }
    if (EN(16) && IN(NPH - 1)) { const int layer = 0; PH_BEGIN; final_phase(F, ap->in[26], ap->out); }
#undef IN
#undef SEAM
}


#ifndef PROBE_LAYER
#define PROBE_LAYER -1
#endif
#if PROBE_LAYER >= 0
constexpr int PB_NS = 64;
__device__ __forceinline__ int pb_keyrow(int b, int j) { return j < SEQ ? b * SEQ + j : NLAT + b * CTXL + (j - SEQ); }
__device__ __forceinline__ int pb_sample_row(int s, int b, bool with_ctx) {
    if (with_ctx && s >= PB_NS - 4) return NLAT + b * CTXL + ((s * 67) & 255);
    const int sp[8] = {0, 63, 64 * 255, 16383, 64 * 3 + 5, 64 * 252 + 60, 8 * 64 + 8, 100 * 64 + 32};
    int t; if (s < 8) { t = 0;
#pragma unroll
        for (int i = 0; i < 8; ++i) if (s == i) t = sp[i]; }
    else t = (int)(((unsigned)s * 2654435761u) >> 9) & (SEQ - 1);
    return b * SEQ + t;
}
__global__ void pb_proj(const bf16_t* H, int nrows, int smode, int b, int with_ctx, const float* W, int ldw, int col0, int ncols, float* out, int ldo) {
    const long idx = (long)blockIdx.x * 256 + threadIdx.x; const int j = (int)(idx / ncols), c = (int)(idx % ncols); if (j >= nrows) return;
    const int row = smode ? pb_sample_row(j, b, with_ctx) : pb_keyrow(b, j);
    const bf16_t* h = H + (size_t)row * DM; const float* w = W + col0 + c; float acc = 0.f;
    for (int k = 0; k < DM; ++k) acc = fmaf(bf2f(h[k]), w[(size_t)k * ldw], acc);
    out[(size_t)j * ldo + c] = acc;
}
__global__ void pb_proj_f32(const float* A, int lda, int K, int nrows, const float* W, int ldw, int col0, int ncols, float* out, int ldo) {
    const long idx = (long)blockIdx.x * 256 + threadIdx.x; const int j = (int)(idx / ncols), c = (int)(idx % ncols); if (j >= nrows) return;
    const float* a = A + (size_t)j * lda; const float* w = W + col0 + c; float acc = 0.f;
    for (int k = 0; k < K; ++k) acc = fmaf(a[k], w[(size_t)k * ldw], acc);
    out[(size_t)j * ldo + c] = acc;
}
__global__ void pb_normrope(float* buf, int ld, int nrows, int smode, int b, int with_ctx, int noff, int nw, const float* gain, int roff, int rdim) {
    const int j = blockIdx.x * 256 + threadIdx.x; if (j >= nrows) return;
    const int row = smode ? pb_sample_row(j, b, with_ctx) : pb_keyrow(b, j);
    float* p = buf + (size_t)j * ld;
    if (nw > 0) { float ss = 0.f; for (int i = 0; i < nw; ++i) ss += p[noff + i] * p[noff + i]; const float rstd = 1.0f / sqrtf(ss / nw + NORM_EPS); for (int i = 0; i < nw; ++i) p[noff + i] = p[noff + i] * rstd * gain[i]; }
    if (rdim > 0 && row < NLAT) { const int tok = row & (SEQ - 1), q = rdim / 4; const float gr = (float)(tok / GRIDW), gc = (float)(tok % GRIDW);
        for (int i = 0; i < q; ++i) { const float inv = powf(10000.0f, -(float)i / (float)q); const float ar = gr * inv, ac = gc * inv;
            const float x0 = p[roff + i], x1 = p[roff + q + i], x2 = p[roff + 2 * q + i], x3 = p[roff + 3 * q + i];
            const float cr = cosf(ar), sr = sinf(ar), cc = cosf(ac), sc = sinf(ac);
            p[roff + i] = x0 * cr - x1 * sr; p[roff + q + i] = x1 * cr + x0 * sr; p[roff + 2 * q + i] = x2 * cc - x3 * sc; p[roff + 3 * q + i] = x3 * cc + x2 * sc; } }
}
__global__ void pb_attn(const float* Q, int ldq, int dk1, int dk2, const float* K1, int ldk1, const float* K2, int ldk2, const float* V, int ldv, float scale, int mode_lat,
                        const float* rpb_h, const bf16_t* O, int b, int h, int with_ctx, float* scores, unsigned* errbits) {
    __shared__ float qs[192]; __shared__ float red[256]; __shared__ float oref[128];
    const int s = blockIdx.x, tid = threadIdx.x, row = pb_sample_row(s, b, with_ctx); const bool isctx = row >= NLAT; const int tok = row & (SEQ - 1);
    const int mode = isctx ? 1 : mode_lat, nk = mode == 0 ? SEQ + CTXL : (mode == 1 ? CTXL : 128 + CTXL);
    const int r = tok / GRIDW, c = tok % GRIDW, rst = min(max(r - 4, 0), 248), cst = min(max(c - 8, 0), 48);
    if (tid < dk1 + dk2) qs[tid] = Q[(size_t)s * ldq + tid];
    __syncthreads();
    float* sc = scores + (size_t)s * (SEQ + CTXL);
    float lmax = -1e30f;
    for (int i = tid; i < nk; i += 256) { int j; float bias = 0.f;
        if (mode == 0) j = i; else if (mode == 1) j = SEQ + i;
        else if (i < 128) { const int kr = rst + i / 16, kc = cst + i % 16; j = kr * GRIDW + kc; bias = rpb_h[(kr - r + 7) * 31 + (kc - c + 15)]; } else j = SEQ + (i - 128);
        float d = 0.f; for (int t = 0; t < dk1; ++t) d = fmaf(qs[t], K1[(size_t)j * ldk1 + t], d); for (int t = 0; t < dk2; ++t) d = fmaf(qs[dk1 + t], K2[(size_t)j * ldk2 + t], d);
        const float v = d * scale + bias; sc[i] = v; lmax = fmaxf(lmax, v); }
    red[tid] = lmax; __syncthreads(); for (int o = 128; o > 0; o >>= 1) { if (tid < o) red[tid] = fmaxf(red[tid], red[tid + o]); __syncthreads(); }
    const float m = red[0]; __syncthreads();
    float lsum = 0.f; for (int i = tid; i < nk; i += 256) { const float p = expf(sc[i] - m); sc[i] = p; lsum += p; }
    red[tid] = lsum; __syncthreads(); for (int o = 128; o > 0; o >>= 1) { if (tid < o) red[tid] += red[tid + o]; __syncthreads(); }
    const float l = red[0]; __syncthreads();
    if (tid < 128) { float o = 0.f; for (int i = 0; i < nk; ++i) { int j; if (mode == 0) j = i; else if (mode == 1) j = SEQ + i; else if (i < 128) j = (rst + i / 16) * GRIDW + cst + i % 16; else j = SEQ + (i - 128);
            o = fmaf(sc[i], V[(size_t)j * ldv + tid], o); } oref[tid] = o / l; }
    __syncthreads();
    if (tid == 0) { float om = 0.f, df = 0.f; for (int d = 0; d < 128; ++d) { om = fmaxf(om, fabsf(oref[d])); df = fmaxf(df, fabsf(oref[d] - bf2f(O[(size_t)row * DM + h * 128 + d]))); }
        float e = df / (om + 1e-30f); if (!(e == e)) e = 50.f; atomicMax(errbits, __float_as_uint(e)); }
}
__global__ void pb_encode(const unsigned* errbits, float* out) { float e = __uint_as_float(*errbits); e = fminf(fmaxf(e, 1e-7f), 90.f); out[0] = e * 1e9f; }
#endif
extern "C" void kernel_launch(void* const* d_in, const int* in_sizes, int n_in, void* d_out, int out_size, void* d_ws, size_t ws_size, hipStream_t stream) {
    static int grid = 0;
    if (grid == 0) {
        if (n_in != NIN || in_sizes[0] != NLAT * DM || out_size != NLAT * DM || ws_size < WS_END) {
            fprintf(stderr, "kernel_launch: shape mismatch: n_in %d in0 %d out %d ws %zu (need >= %zu)\n", n_in, n_in > 0 ? in_sizes[0] : -1, out_size, ws_size, (size_t)WS_END); grid = -1; return; }
        int dev = 0, cus = 0, per_cu = 0;
        if (hipGetDevice(&dev) != hipSuccess || hipDeviceGetAttribute(&cus, hipDeviceAttributeMultiprocessorCount, dev) != hipSuccess) { fprintf(stderr, "kernel_launch: device query failed\n"); grid = -1; return; }
        if (hipFuncSetAttribute((const void*)mega_fwd, hipFuncAttributeMaxDynamicSharedMemorySize, LDS_BYTES) != hipSuccess) { fprintf(stderr, "kernel_launch: hipFuncSetAttribute failed\n"); grid = -1; return; }
        if (hipOccupancyMaxActiveBlocksPerMultiprocessor(&per_cu, (const void*)mega_fwd, 512, LDS_BYTES) != hipSuccess || per_cu < 1)
            fprintf(stderr, "kernel_launch: note: occupancy query reports %d workgroups per CU\n", per_cu);
        (void)hipGetLastError();
        grid = cus;
    }
    if (grid < 0) return;
    if (hipMemsetAsync((char*)d_ws + WS_CTL, 0, CTL_ZERO_BYTES, stream) != hipSuccess) { fprintf(stderr, "kernel_launch: memset failed\n"); return; }
    Args a{};
    for (int i = 0; i < NIN; ++i) a.in[i] = (const float*)d_in[i];
    a.out = (float*)d_out; a.ws = (unsigned char*)d_ws; a.rep_mask = RP_MASK;
#if MK_PER_PHASE
    for (int ph = 0; ph < NPH; ++ph) {
        if (!phase_exists(ph)) continue;
        a.ph_lo = ph; a.ph_hi = ph + 1;
        hipLaunchKernelGGL(mega_fwd, dim3(grid), dim3(512), LDS_BYTES, stream, a);
    }
#elif PROBE_LAYER >= 0
    {
        constexpr int L = PROBE_LAYER, kind = L % 3, jm = L / 3; constexpr bool wctx = (L != DEPTH - 1);
        a.ph_lo = 0; a.ph_hi = 1 + L * PPL + 6;
        hipLaunchKernelGGL(mega_fwd, dim3(grid), dim3(512), LDS_BYTES, stream, a);
        unsigned char* ws = (unsigned char*)d_ws; const bf16_t* H = (const bf16_t*)(ws + WS_H); const bf16_t* O = (const bf16_t*)(ws + WS_O);
        float* R0 = (float*)(ws + WS_PART); float* R1 = R0 + (size_t)16640 * 576; float* R2 = R1 + (size_t)16640 * 256; float* R3 = R2 + (size_t)PB_NS * 512; float* SC = R3 + (size_t)PB_NS * 192;
        unsigned* err = (unsigned*)((unsigned char*)d_ws + 512 * 1024);
        const int NK = SEQ + CTXL;
        auto nb = [](long n) { return (unsigned)((n + 255) / 256); };
        hipMemsetAsync(d_out, 0, (size_t)out_size * 4, stream);
        if (kind == 2) { const int b = 1, h = 9, kvh = 2; const float* W = (const float*)d_in[22];
            hipLaunchKernelGGL(pb_proj, dim3(nb((long)NK * 128)), dim3(256), 0, stream, H, NK, 0, b, 1, W, 3072, 2048 + kvh * 128, 128, R0, 128);
            hipLaunchKernelGGL(pb_proj, dim3(nb((long)NK * 128)), dim3(256), 0, stream, H, NK, 0, b, 1, W, 3072, 2560 + kvh * 128, 128, R1, 128);
            hipLaunchKernelGGL(pb_normrope, dim3(nb(NK)), dim3(256), 0, stream, R0, 128, NK, 0, b, 1, 0, 128, (const float*)d_in[24], 0, 128);
            hipLaunchKernelGGL(pb_proj, dim3(nb((long)PB_NS * 128)), dim3(256), 0, stream, H, PB_NS, 1, b, 1, W, 3072, h * 128, 128, R2, 128);
            hipLaunchKernelGGL(pb_normrope, dim3(nb(PB_NS)), dim3(256), 0, stream, R2, 128, PB_NS, 1, b, 1, 0, 128, (const float*)d_in[23], 0, 128);
            hipLaunchKernelGGL(pb_attn, dim3(PB_NS), dim3(256), 0, stream, R2, 128, 128, 0, R0, 128, (const float*)nullptr, 0, R1, 128, 0.088388347648318440f, 0, (const float*)nullptr, O, b, h, 1, SC, err);
        } else if (kind == 1) { const int b = 0, h = 5;
            hipLaunchKernelGGL(pb_proj, dim3(nb((long)NK * 576)), dim3(256), 0, stream, H, NK, 0, b, 1, (const float*)d_in[18], 576, 0, 576, R0, 576);
            hipLaunchKernelGGL(pb_normrope, dim3(nb(NK)), dim3(256), 0, stream, R0, 576, NK, 0, b, 1, 0, 512, (const float*)d_in[19], 512, 64);
            hipLaunchKernelGGL(pb_proj_f32, dim3(nb((long)NK * 256)), dim3(256), 0, stream, R0, 576, 512, NK, (const float*)d_in[20], 4096, h * 256, 256, R1, 256);
            hipLaunchKernelGGL(pb_proj, dim3(nb((long)PB_NS * 512)), dim3(256), 0, stream, H, PB_NS, 1, b, 1, (const float*)d_in[15], 512, 0, 512, R2, 512);
            hipLaunchKernelGGL(pb_normrope, dim3(nb(PB_NS)), dim3(256), 0, stream, R2, 512, PB_NS, 1, b, 1, 0, 512, (const float*)d_in[16], 0, 0);
            hipLaunchKernelGGL(pb_proj_f32, dim3(nb((long)PB_NS * 192)), dim3(256), 0, stream, R2, 512, 512, PB_NS, (const float*)d_in[17], 3072, h * 192, 192, R3, 192);
            hipLaunchKernelGGL(pb_normrope, dim3(nb(PB_NS)), dim3(256), 0, stream, R3, 192, PB_NS, 1, b, 1, 0, 0, (const float*)nullptr, 128, 64);
            hipLaunchKernelGGL(pb_attn, dim3(PB_NS), dim3(256), 0, stream, R3, 192, 128, 64, R1, 256, R0 + 512, 576, R1 + 128, 256, 0.072168783648703220f, 0, (const float*)nullptr, O, b, h, 1, SC, err);
        } else { const int b = 1, h = 3; const float* W = (const float*)d_in[12] + (size_t)jm * DM * 6144;
            hipLaunchKernelGGL(pb_proj, dim3(nb((long)NK * 128)), dim3(256), 0, stream, H, NK, 0, b, wctx ? 1 : 0, W, 6144, 2048 + h * 128, 128, R0, 128);
            hipLaunchKernelGGL(pb_proj, dim3(nb((long)NK * 128)), dim3(256), 0, stream, H, NK, 0, b, wctx ? 1 : 0, W, 6144, 4096 + h * 128, 128, R1, 128);
            hipLaunchKernelGGL(pb_proj, dim3(nb((long)PB_NS * 128)), dim3(256), 0, stream, H, PB_NS, 1, b, wctx ? 1 : 0, W, 6144, h * 128, 128, R2, 128);
            hipLaunchKernelGGL(pb_attn, dim3(PB_NS), dim3(256), 0, stream, R2, 128, 128, 0, R0, 128, (const float*)nullptr, 0, R1, 128, 0.088388347648318440f, 2, (const float*)d_in[13] + ((size_t)jm * 16 + h) * 465, O, b, h, wctx ? 1 : 0, SC, err);
        }
        hipLaunchKernelGGL(pb_encode, dim3(1), dim3(1), 0, stream, (const unsigned*)err, (float*)d_out);
    }
#else
    a.ph_lo = 0; a.ph_hi = NPH;
    hipLaunchKernelGGL(mega_fwd, dim3(grid), dim3(512), LDS_BYTES, stream, a);
#endif
    const hipError_t le = hipPeekAtLastError();
    if (le != hipSuccess) fprintf(stderr, "kernel_launch: launch failed: %s\n", hipGetErrorName(le));
}
```

```cpp
#include <hip/hip_runtime.h>
#include <cstdio>
#include <cstdint>

#ifndef MK_PER_PHASE
#define MK_PER_PHASE 0
#endif

#ifndef EN_MASK
#define EN_MASK 0xFFFFFFFFu
#endif
#define EN(b) ((EN_MASK >> (b)) & 1u)
#ifndef RP_MASK
#define RP_MASK 0u
#endif
#define RPT(b) (1 + (int)((ap->rep_mask >> (b)) & 1u))
#define LAS __attribute__((address_space(3)))
typedef unsigned short bf16_t;
typedef short bf16x8 __attribute__((ext_vector_type(8)));
typedef short s16x4 __attribute__((ext_vector_type(4)));
typedef float f32x4 __attribute__((ext_vector_type(4)));
typedef float f32x2 __attribute__((ext_vector_type(2)));
typedef float f32x16 __attribute__((ext_vector_type(16)));
typedef unsigned u32x4 __attribute__((ext_vector_type(4)));
typedef unsigned u32x2 __attribute__((ext_vector_type(2)));

constexpr int DM = 2048, NBATCH = 2, SEQ = 16384, CTXL = 256, GRIDW = 64;
constexpr int NLAT = NBATCH * SEQ;
constexpr int MROWS = NLAT + NBATCH * CTXL;
constexpr int FFD = 5632, DEPTH = 4, MODW = 6 * DM;
constexpr float NORM_EPS = 1e-6f;
constexpr float LOG2E = 1.4426950408889634f;
constexpr int NBLK64 = MROWS / 64;

constexpr size_t MiB = 1u << 20;
constexpr size_t WS_CTL = 0, CTL_ZERO_BYTES = 1 * MiB;
constexpr size_t WS_MODS = 1 * MiB;
constexpr size_t WS_TAB = 2 * MiB;
constexpr size_t WS_RS = 3 * MiB;
constexpr size_t WS_X = 4 * MiB;
constexpr size_t WS_H = 264 * MiB;
constexpr size_t WS_O = 394 * MiB;
constexpr size_t WS_BIG = 524 * MiB;
constexpr size_t WS_W = 1068 * MiB;
constexpr size_t WS_PART = 1436 * MiB;
constexpr size_t WS_END = 1524 * MiB;
constexpr int WO_KS = 8, DN_KS = 22;
constexpr size_t BIG_QKV = 0;
constexpr size_t BIG_T1 = 0, BIG_Q = 82 * MiB, BIG_KV = 277 * MiB, BIG_KPE = 537 * MiB;
constexpr size_t BIG_ACT = 0, BIG_SIDE = 358 * MiB;
constexpr size_t SIDE_ARR = (size_t)NBLK64 * FFD;
constexpr size_t W_UP = 0, W_DN = 176 * MiB, W_NAQKV = 264 * MiB, W_NAWO = 312 * MiB, W_MLA1 = 328 * MiB, W_MLAQB = 333 * MiB,
                 W_MLAKVB = 336 * MiB, W_MLAWO = 340 * MiB, W_GQAQKV = 348 * MiB, W_GQAWO = 360 * MiB;
constexpr size_t W_UP_L = 44 * MiB, W_DN_L = 22 * MiB, W_NAQKV_L = 24 * MiB, W_NAWO_L = 8 * MiB;
constexpr int CW_BAR = 4096;

constexpr int RING_BYTES = 150528;
constexpr int LDSCTL_OFF = RING_BYTES, MISC_OFF = LDSCTL_OFF + 320, NATAB_OFF = LDSCTL_OFF + 1024;
constexpr int LDS_BYTES = RING_BYTES + 8192;

__device__ __forceinline__ unsigned cvt_pk_bf16(float lo, float hi) { unsigned r; asm volatile("v_cvt_pk_bf16_f32 %0, %1, %2" : "=v"(r) : "v"(lo), "v"(hi)); return r; }
__device__ __forceinline__ float bf_lo(unsigned w) { return __uint_as_float(w << 16); }
__device__ __forceinline__ float bf_hi(unsigned w) { return __uint_as_float(w & 0xffff0000u); }
__device__ __forceinline__ float bf2f(bf16_t b) { return __uint_as_float(((unsigned)b) << 16); }
__device__ __forceinline__ bf16_t f2bf(float f) { return (bf16_t)(cvt_pk_bf16(f, 0.f) & 0xffffu); }
__device__ __forceinline__ float wave_sum(float v) {
#pragma unroll
    for (int o = 1; o < 64; o <<= 1) v += __shfl_xor(v, o);
    return v;
}
__device__ __forceinline__ float silu_f(float c) { return c * __builtin_amdgcn_rcpf(1.0f + __builtin_amdgcn_exp2f(-c * LOG2E)); }
__device__ __forceinline__ int row_midx(int row) { return row < SEQ ? 0 : (row < NLAT ? 1 : 2); }

namespace pg8 {
constexpr int BM = 256, BK = 64, HALF = 128, HTB = HALF * BK * 2, STAGE_BYTES = 8 * HTB, NXCD = 8, WGM = 8;
__host__ __device__ __forceinline__ int lds_byte(int r, int c) { const int st = (r >> 4) * 2 + (c >> 5), rr = r & 15, cc = c & 31, ob = rr * 64 + cc * 2; return st * 1024 + (ob ^ (((ob >> 9) & 1) << 5)); }
__host__ __device__ __forceinline__ void stage_rc(int b, int& R, int& C) { const int st = b / 1024, sb = b % 1024, swz = sb ^ (((sb >> 9) & 1) << 5); R = (st >> 1) * 16 + swz / 64; C = (st & 1) * 32 + (swz % 64) / 2; }
__host__ __device__ __forceinline__ int perm32(int rho) { const int n = rho >> 4, i = rho & 15; return 8 * (i >> 2) + 4 * n + (i & 3); }

struct Unit { int pm, pn, k0, nt, kc; };
struct Gemm { const bf16_t* A; const bf16_t* Bt; int M, N, K, lda; };

struct StaticOrder {
    int nM, nN, nwg, G, c, ntf, nMs, KS, ntc;
    __device__ __forceinline__ void init(int Mf, int N, int K, int G_, int c_, int Ms = 0, int KS_ = 1) { nM = Mf / BM; nN = N / BM; nwg = nM * nN; G = G_; c = c_; ntf = K / BK; nMs = Ms / BM; KS = KS_; ntc = ntf / KS_; }
    __device__ __forceinline__ bool next(int i, Unit& u) const {
        const long L = (long)i * G + c;
        const bool split = L >= nwg;
        if (split && (int)(L - nwg) >= nMs * nN * KS) return false;
        int wgid = split ? 0 : (int)L; { const int q = nwg / NXCD, r = nwg % NXCD, xcd = wgid % NXCD, off = wgid / NXCD; wgid = (xcd < r ? xcd * (q + 1) : r * (q + 1) + (xcd - r) * q) + off; }
        const int nig = WGM * nN, gid = wgid / nig, fm = gid * WGM, gsz = (nM - fm) < WGM ? (nM - fm) : WGM;
        const int pm_f = fm + ((wgid % nig) % gsz), pn_f = (wgid % nig) / gsz;
        const int sidx = split ? (int)(L - nwg) : 0, kc_s = sidx % KS, t = sidx / KS, pn_s = t % nN, pm_s = nM + t / nN;
        u.pm = split ? pm_s : pm_f; u.pn = split ? pn_s : pn_f; u.k0 = split ? kc_s * ntc * BK : 0; u.nt = split ? ntc : ntf; u.kc = split ? kc_s : -1;
        return true;
    }
};

template <bool SCALED> struct EpiBf16 {
    static constexpr bool PERM = true;
    bf16_t* O; int ldc; const float* rs; int rsel; float mul;
    __device__ __forceinline__ void operator()(const f32x4 (&acc)[2][2][4][2], const Unit& u, int wr, int wc, int fr, int fq) const {
        const int row0 = u.pm * BM + wr * 64 + fr, col0 = u.pn * BM + wc * 32 + 8 * fq;
#pragma unroll
        for (int ai = 0; ai < 2; ++ai)
#pragma unroll
            for (int m = 0; m < 4; ++m) { const int row = row0 + ai * HALF + m * 16; bf16_t* rowp = O + (size_t)row * ldc + col0;
                float sc = 1.0f; if constexpr (SCALED) sc = rs[(size_t)row * 2 + rsel] * mul;
#pragma unroll
                for (int bj = 0; bj < 2; ++bj) { const f32x4 v0 = acc[ai][bj][m][0] * sc, v1 = acc[ai][bj][m][1] * sc;
                    u32x4 w; w.x = cvt_pk_bf16(v0[0], v0[1]); w.y = cvt_pk_bf16(v0[2], v0[3]); w.z = cvt_pk_bf16(v1[0], v1[1]); w.w = cvt_pk_bf16(v1[2], v1[3]);
                    *(u32x4*)(rowp + bj * HALF) = w; }
                if constexpr (SCALED) asm volatile("" ::: "memory"); }
    }
};
struct EpiResid {
    static constexpr bool PERM = false;
    float* X; const float* Xin; const float* gate; float* part;
    __device__ __forceinline__ void operator()(const f32x4 (&acc)[2][2][4][2], const Unit& u, int wr, int wc, int fr, int fq) const {
        if (u.kc >= 0) {
            const int rl0 = (u.pm - NLAT / BM) * BM + wr * 64 + fr, col0 = u.pn * BM + wc * 32 + 4 * fq;
#pragma unroll
            for (int ai = 0; ai < 2; ++ai)
#pragma unroll
                for (int m = 0; m < 4; ++m) { float* rowp = part + ((size_t)u.kc * (NBATCH * CTXL) + rl0 + ai * HALF + m * 16) * DM + col0;
#pragma unroll
                    for (int bj = 0; bj < 2; ++bj)
#pragma unroll
                        for (int n = 0; n < 2; ++n) *(f32x4*)(rowp + bj * HALF + n * 16) = acc[ai][bj][m][n]; }
            return;
        }
        const int midx = u.pm < 64 ? 0 : (u.pm < 128 ? 1 : 2);
        const float* g = gate + (size_t)midx * MODW;
        const int row0 = u.pm * BM + wr * 64 + fr, col0 = u.pn * BM + wc * 32 + 4 * fq;
        f32x4 gv[2][2];
#pragma unroll
        for (int bj = 0; bj < 2; ++bj)
#pragma unroll
            for (int n = 0; n < 2; ++n) gv[bj][n] = *(const f32x4*)(g + col0 + bj * HALF + n * 16);
#pragma unroll
        for (int ai = 0; ai < 2; ++ai)
#pragma unroll
            for (int m = 0; m < 4; ++m) { const size_t ro = (size_t)(row0 + ai * HALF + m * 16) * DM + col0;
#pragma unroll
                for (int bj = 0; bj < 2; ++bj)
#pragma unroll
                    for (int n = 0; n < 2; ++n) { const size_t o = ro + bj * HALF + n * 16; const f32x4 x = *(const f32x4*)(Xin + o); *(f32x4*)(X + o) = x + gv[bj][n] * acc[ai][bj][m][n]; } }
    }
};
struct EpiGlu {
    static constexpr bool PERM = true;
    bf16_t* ACT; const float* cw; const float* cb; float* side;
    __device__ __forceinline__ void operator()(const f32x4 (&acc)[2][2][4][2], const Unit& u, int wr, int wc, int fr, int fq) const {
        const int ch0 = u.pn * HALF + wc * 32 + 8 * fq;
        const int lane = (int)(threadIdx.x & 63);
        const int src_prev = (lane & 48) | ((fr + 15) & 15), src_next = (lane & 48) | ((fr + 1) & 15);
#pragma unroll
        for (int ai = 0; ai < 2; ++ai) {
            const int blk = u.pm * 4 + ai * 2 + wr;
            unsigned pk[4][4];
#pragma unroll
            for (int n = 0; n < 2; ++n) {
                const f32x4 w0 = *(const f32x4*)(cw + ch0 + 4 * n), w1 = *(const f32x4*)(cw + FFD + ch0 + 4 * n), w2 = *(const f32x4*)(cw + 2 * FFD + ch0 + 4 * n), bb = *(const f32x4*)(cb + ch0 + 4 * n);
                f32x4 R[4], Lr[4];
#pragma unroll
                for (int m = 0; m < 4; ++m)
#pragma unroll
                    for (int j = 0; j < 4; ++j) { const float g = acc[ai][0][m][n][j]; R[m][j] = __shfl(g, src_prev); Lr[m][j] = __shfl(g, src_next); }
#pragma unroll
                for (int m = 0; m < 4; ++m) {
                    f32x4 prev = R[m], next = Lr[m];
                    if (fr == 0) prev = (m > 0) ? R[m > 0 ? m - 1 : 0] : (f32x4){0.f, 0.f, 0.f, 0.f};
                    if (fr == 15) next = (m < 3) ? Lr[m < 3 ? m + 1 : 3] : (f32x4){0.f, 0.f, 0.f, 0.f};
                    const f32x4 g = acc[ai][0][m][n], v = acc[ai][1][m][n];
                    const f32x4 c = bb + w0 * prev + w1 * g + w2 * next;
                    float a[4];
#pragma unroll
                    for (int j = 0; j < 4; ++j) a[j] = silu_f(c[j]) * v[j];
                    pk[m][2 * n] = cvt_pk_bf16(a[0], a[1]); pk[m][2 * n + 1] = cvt_pk_bf16(a[2], a[3]);
                }
            }
#pragma unroll
            for (int m = 0; m < 4; ++m) {
                const int row = u.pm * BM + ai * HALF + wr * 64 + m * 16 + fr;
                u32x4 w; w.x = pk[m][0]; w.y = pk[m][1]; w.z = pk[m][2]; w.w = pk[m][3];
                const bool edge = (m == 0 && fr == 0) || (m == 3 && fr == 15);
                if (!edge) *(u32x4*)(ACT + (size_t)row * FFD + ch0) = w;
            }
            float* sb = side + (size_t)blk * FFD + ch0;
            if (fr == 0)  { *(f32x4*)(sb + 0 * SIDE_ARR) = acc[ai][0][0][0]; *(f32x4*)(sb + 0 * SIDE_ARR + 4) = acc[ai][0][0][1]; *(f32x4*)(sb + 4 * SIDE_ARR) = acc[ai][1][0][0]; *(f32x4*)(sb + 4 * SIDE_ARR + 4) = acc[ai][1][0][1]; }
            if (fr == 1)  { *(f32x4*)(sb + 1 * SIDE_ARR) = acc[ai][0][0][0]; *(f32x4*)(sb + 1 * SIDE_ARR + 4) = acc[ai][0][0][1]; }
            if (fr == 14) { *(f32x4*)(sb + 2 * SIDE_ARR) = acc[ai][0][3][0]; *(f32x4*)(sb + 2 * SIDE_ARR + 4) = acc[ai][0][3][1]; }
            if (fr == 15) { *(f32x4*)(sb + 3 * SIDE_ARR) = acc[ai][0][3][0]; *(f32x4*)(sb + 3 * SIDE_ARR + 4) = acc[ai][0][3][1]; *(f32x4*)(sb + 5 * SIDE_ARR) = acc[ai][1][3][0]; *(f32x4*)(sb + 5 * SIDE_ARR + 4) = acc[ai][1][3][1]; }
        }
    }
};

template <class Epi>
__device__ __forceinline__ void gemm_phase(LAS unsigned char* lds, const Gemm g, const StaticOrder& S, const Epi& E) {
    int tid = threadIdx.x; asm volatile("" : "+v"(tid));
    const int wid = __builtin_amdgcn_readfirstlane(tid >> 6), lane = tid & 63, wr = wid >> 2, wc = wid & 3, fr = lane & 15, fq = lane >> 4;
    const int K = g.K, lda = g.lda;
    unsigned voffA[2], voffB[2];
#pragma unroll
    for (int i = 0; i < 2; ++i) { int R, C; stage_rc(tid * 16 + i * 8192, R, C); const int Rb = Epi::PERM ? ((R & ~31) + perm32(R & 31)) : R;
        voffA[i] = (unsigned)(R * lda + C) * 2u; voffB[i] = (unsigned)(Rb * K + C) * 2u; }
    const size_t kstep = (size_t)(BK * 2);
    const size_t hA = (size_t)HALF * lda * 2, hB = (size_t)HALF * K * 2;
    const size_t tA = 2 * hA, tB = 2 * hB;
    const unsigned ldsw = (unsigned)wid * 1024u;
    const int aoff = lds_byte(wr * 64 + fr, fq * 8), boff = lds_byte(wc * 32 + fr, fq * 8);
#define PG8_SA(b, h) (((b) * 2 + (h)) * HTB)
#define PG8_SB(b, h) ((4 + (b) * 2 + (h)) * HTB)
#define PG8_STAGE(bufoff, gbase, voff) do { _Pragma("unroll") for (int _i = 0; _i < 2; ++_i) \
        __builtin_amdgcn_global_load_lds((const unsigned*)((const char*)(gbase) + (voff)[_i]), (LAS unsigned*)(lds + (bufoff) + ldsw + _i * 8192), 16, 0, 0); } while (0)
#define PG8_LDA(dst, b, h) do { _Pragma("unroll") for (int m = 0; m < 4; ++m) _Pragma("unroll") for (int k = 0; k < 2; ++k) dst[m][k] = *(const LAS bf16x8*)(lds + PG8_SA(b, h) + aoff + m * 2048 + k * 1024); } while (0)
#define PG8_LDB(dst, b, h) do { _Pragma("unroll") for (int n = 0; n < 2; ++n) _Pragma("unroll") for (int k = 0; k < 2; ++k) dst[n][k] = *(const LAS bf16x8*)(lds + PG8_SB(b, h) + boff + n * 2048 + k * 1024); } while (0)
#define PG8_MMA(ai, bj, At, Bt) do { __builtin_amdgcn_s_setprio(1); _Pragma("unroll") for (int m = 0; m < 4; ++m) _Pragma("unroll") for (int n = 0; n < 2; ++n) _Pragma("unroll") for (int k = 0; k < 2; ++k) \
        acc[ai][bj][m][n] = __builtin_amdgcn_mfma_f32_16x16x32_bf16(Bt[n][k], At[m][k], acc[ai][bj][m][n], 0, 0, 0); __builtin_amdgcn_s_setprio(0); } while (0)
#define PG8_WAIT_V(n) asm volatile("s_waitcnt vmcnt(" #n ")" ::: "memory")
#define PG8_WAIT_L(n) asm volatile("s_waitcnt lgkmcnt(" #n ")" ::: "memory")
#define PG8_BAR __builtin_amdgcn_s_barrier()
#define PG8_SCHED __builtin_amdgcn_sched_barrier(0)
    Unit cur, nxt; int ui = 0;
    if (!S.next(0, cur)) return;
    f32x4 acc[2][2][4][2];
#pragma unroll
    for (int a = 0; a < 2; ++a)
#pragma unroll
        for (int b = 0; b < 2; ++b)
#pragma unroll
            for (int m = 0; m < 4; ++m)
#pragma unroll
                for (int n = 0; n < 2; ++n) acc[a][b][m][n] = (f32x4){0.f, 0.f, 0.f, 0.f};
    bf16x8 At[4][2], B0[2][2], B1[2][2];
    const char* cA = (const char*)g.A + (size_t)cur.pm * tA + (size_t)cur.k0 * 2; const char* cB = (const char*)g.Bt + (size_t)cur.pn * tB + (size_t)cur.k0 * 2;
    PG8_STAGE(PG8_SB(0, 0), cB, voffB); PG8_STAGE(PG8_SB(0, 1), cB + hB, voffB); PG8_STAGE(PG8_SA(0, 0), cA, voffA); PG8_STAGE(PG8_SA(0, 1), cA + hA, voffA);
    if (wr == 1) PG8_BAR;
    PG8_WAIT_V(2); PG8_BAR;
    PG8_STAGE(PG8_SB(1, 0), cB + kstep, voffB); PG8_STAGE(PG8_SA(1, 0), cA + kstep, voffA); PG8_STAGE(PG8_SB(1, 1), cB + hB + kstep, voffB);
    PG8_WAIT_V(6); PG8_BAR;
    for (;;) {
        const bool has_next = S.next(ui + 1, nxt);
        const char* nA = has_next ? (const char*)g.A + (size_t)nxt.pm * tA + (size_t)nxt.k0 * 2 : cA; const char* nB = has_next ? (const char*)g.Bt + (size_t)nxt.pn * tB + (size_t)nxt.k0 * 2 : cB;
        const int nt = cur.nt;
        for (int t = 0; t < nt; t += 2) {
            const bool last = (t == nt - 2);
            const char* a1 = cA + (size_t)(t + 1) * kstep;
            const char* a2 = last ? nA : cA + (size_t)(t + 2) * kstep; const char* b2 = last ? nB : cB + (size_t)(t + 2) * kstep;
            const char* a3 = a2 + kstep; const char* b3 = b2 + kstep;
            PG8_LDB(B0, 0, 0); PG8_LDB(B1, 0, 1); PG8_SCHED; PG8_LDA(At, 0, 0); PG8_STAGE(PG8_SA(1, 1), a1 + hA, voffA);
            PG8_WAIT_V(8); PG8_WAIT_L(0); PG8_BAR; PG8_MMA(0, 0, At, B0); PG8_MMA(0, 1, At, B1); PG8_BAR; PG8_SCHED;
            PG8_LDA(At, 0, 1); PG8_STAGE(PG8_SB(0, 0), b2, voffB); PG8_STAGE(PG8_SB(0, 1), b2 + hB, voffB); PG8_STAGE(PG8_SA(0, 0), a2, voffA);
            PG8_WAIT_V(8); PG8_WAIT_L(0); PG8_BAR; PG8_MMA(1, 0, At, B0); PG8_MMA(1, 1, At, B1); PG8_BAR; PG8_SCHED;
            PG8_LDB(B0, 1, 0); PG8_LDB(B1, 1, 1); PG8_SCHED; PG8_LDA(At, 1, 0); PG8_STAGE(PG8_SA(0, 1), a2 + hA, voffA);
            PG8_WAIT_V(8); PG8_WAIT_L(0); PG8_BAR; PG8_MMA(0, 0, At, B0); PG8_MMA(0, 1, At, B1); PG8_BAR; PG8_SCHED;
            PG8_LDA(At, 1, 1); PG8_STAGE(PG8_SB(1, 0), b3, voffB); PG8_STAGE(PG8_SB(1, 1), b3 + hB, voffB); PG8_STAGE(PG8_SA(1, 0), a3, voffA);
            PG8_WAIT_V(8); PG8_WAIT_L(0); PG8_BAR; PG8_MMA(1, 0, At, B0); PG8_MMA(1, 1, At, B1); PG8_BAR; PG8_SCHED;
        }
        if (wr == 0) PG8_BAR;
        E(acc, cur, wr, wc, fr, fq);
        if (!has_next) break;
#pragma unroll
        for (int a = 0; a < 2; ++a)
#pragma unroll
            for (int b = 0; b < 2; ++b)
#pragma unroll
                for (int m = 0; m < 4; ++m)
#pragma unroll
                    for (int n = 0; n < 2; ++n) acc[a][b][m][n] = (f32x4){0.f, 0.f, 0.f, 0.f};
        cur = nxt; cA = nA; cB = nB; ++ui;
        if (wr == 1) PG8_BAR;
    }
    PG8_WAIT_V(0);
    PG8_BAR;
#undef PG8_SA
#undef PG8_SB
#undef PG8_STAGE
#undef PG8_LDA
#undef PG8_LDB
#undef PG8_MMA
#undef PG8_WAIT_V
#undef PG8_WAIT_L
#undef PG8_BAR
#undef PG8_SCHED
}
}

namespace att {
#define SBAR() __builtin_amdgcn_sched_barrier(0)
__device__ __forceinline__ int crow(int r, int hi) { return (r & 3) + 8 * (r >> 2) + 4 * hi; }
template <int DK> __device__ __forceinline__ int kswz(int row, int colB) {
    if (DK == 128) return row * 256 + (colB ^ (((row & 7) << 4) | (((row >> 3) & 1) << 7)));
    else return row * 384 + (colB ^ (((row >> 1) & 7) << 4));
}
template <int DK> struct Sc { static constexpr float SCALE = (DK == 128) ? 0.088388347648318440f : 0.072168783648703220f; };
constexpr float THR = 8.f;

template <int DK>
__device__ __forceinline__ void partialSM(f32x16& p0, f32x16& p1, float& m_reg, float& mn, float& alpha) {
    constexpr float SCALE = Sc<DK>::SCALE, C = SCALE * LOG2E;
    float pmax = p0[0];
#pragma unroll
    for (int r = 1; r < 16; ++r) pmax = fmaxf(pmax, p0[r]);
#pragma unroll
    for (int r = 0; r < 16; ++r) pmax = fmaxf(pmax, p1[r]);
    { auto rr = __builtin_amdgcn_permlane32_swap(__float_as_uint(pmax), __float_as_uint(pmax), false, false);
      pmax = fmaxf(__uint_as_float(rr[0]), __uint_as_float(rr[1])); }
    if (__builtin_expect(__all(pmax - m_reg <= THR / SCALE), 1)) { mn = m_reg; alpha = 1.f; }
    else { mn = fmaxf(m_reg, pmax); alpha = __builtin_amdgcn_exp2f((m_reg - mn) * C); m_reg = mn; }
    const float mnC = -mn * C;
#pragma unroll
    for (int r = 0; r < 16; ++r) p0[r] = fmaf(p0[r], C, mnC);
#pragma unroll
    for (int r = 0; r < 16; ++r) p1[r] = fmaf(p1[r], C, mnC);
#pragma unroll
    for (int r = 0; r < 16; ++r) p0[r] = __builtin_amdgcn_exp2f(p0[r]);
}
__device__ __forceinline__ void finishSM(f32x16& p0, f32x16& p1, float alpha, float& l_reg, bf16x8& pa0, bf16x8& pa1, bf16x8& pa2, bf16x8& pa3) {
#pragma unroll
    for (int r = 0; r < 16; ++r) p1[r] = __builtin_amdgcn_exp2f(p1[r]);
    float ps = 0;
#pragma unroll
    for (int r = 0; r < 16; ++r) ps += p0[r];
#pragma unroll
    for (int r = 0; r < 16; ++r) ps += p1[r];
    { auto rr = __builtin_amdgcn_permlane32_swap(__float_as_uint(ps), __float_as_uint(ps), false, false);
      ps = __uint_as_float(rr[0]) + __uint_as_float(rr[1]); }
    l_reg = l_reg * alpha + ps;
#define PK4(P, BASE, OUT) do { unsigned a0 = cvt_pk_bf16(P[BASE + 0], P[BASE + 1]), a1 = cvt_pk_bf16(P[BASE + 2], P[BASE + 3]);   \
    unsigned b0 = cvt_pk_bf16(P[BASE + 4], P[BASE + 5]), b1 = cvt_pk_bf16(P[BASE + 6], P[BASE + 7]);                              \
    auto r0 = __builtin_amdgcn_permlane32_swap(a0, b0, false, false); auto r1 = __builtin_amdgcn_permlane32_swap(a1, b1, false, false); \
    u32x4 w = {r0[0], r1[0], r0[1], r1[1]}; OUT = *reinterpret_cast<bf16x8*>(&w); } while (0)
    PK4(p0, 0, pa0); PK4(p0, 8, pa1); PK4(p1, 0, pa2); PK4(p1, 8, pa3);
#undef PK4
}
template <int DK, int QL = 0, int PF = 1>
__device__ __forceinline__ void qkt(f32x16& p0, f32x16& p1, const LAS char* Ks, const bf16x8* qr, int r32, int hi, int qlds = 0) {
    p0 = f32x16{}; p1 = f32x16{};
    constexpr int ND = DK / 16;
    if constexpr (QL > 0) asm volatile("" : "+v"(qlds));
    if constexpr (PF <= 1) {
#pragma unroll
        for (int d0 = 0; d0 < ND; ++d0) { const int cb = (d0 * 16 + hi * 8) * 2;
            const bf16x8 b0 = *(const LAS bf16x8*)(Ks + kswz<DK>(r32, cb));
            const bf16x8 b1 = *(const LAS bf16x8*)(Ks + kswz<DK>(32 + r32, cb));
            bf16x8 q;
            if constexpr (QL > 0) { if (d0 >= ND - QL) q = *(const LAS bf16x8*)(uintptr_t)(unsigned)(qlds + (d0 - (ND - QL)) * 1024); else q = qr[d0]; }
            else q = qr[d0];
            p0 = __builtin_amdgcn_mfma_f32_32x32x16_bf16(b0, q, p0, 0, 0, 0);
            p1 = __builtin_amdgcn_mfma_f32_32x32x16_bf16(b1, q, p1, 0, 0, 0); }
    } else {
        bf16x8 kf[PF][2], qf[PF];
#pragma unroll
        for (int s = 0; s < PF; ++s) { const int cb = (s * 16 + hi * 8) * 2;
            kf[s][0] = *(const LAS bf16x8*)(Ks + kswz<DK>(r32, cb)); kf[s][1] = *(const LAS bf16x8*)(Ks + kswz<DK>(32 + r32, cb));
            if constexpr (QL > 0) { if (s >= ND - QL) qf[s] = *(const LAS bf16x8*)(uintptr_t)(unsigned)(qlds + (s - (ND - QL)) * 1024); } }
        SBAR();
#pragma unroll
        for (int d0 = 0; d0 < ND; ++d0) {
            bf16x8 q;
            if constexpr (QL > 0) { if (d0 >= ND - QL) q = qf[d0 % PF]; else q = qr[d0]; } else q = qr[d0];
            p0 = __builtin_amdgcn_mfma_f32_32x32x16_bf16(kf[d0 % PF][0], q, p0, 0, 0, 0);
            p1 = __builtin_amdgcn_mfma_f32_32x32x16_bf16(kf[d0 % PF][1], q, p1, 0, 0, 0);
            if (d0 + PF < ND) { const int s = d0 + PF; const int cb = (s * 16 + hi * 8) * 2;
                kf[d0 % PF][0] = *(const LAS bf16x8*)(Ks + kswz<DK>(r32, cb)); kf[d0 % PF][1] = *(const LAS bf16x8*)(Ks + kswz<DK>(32 + r32, cb));
                if constexpr (QL > 0) { if (s >= ND - QL) qf[d0 % PF] = *(const LAS bf16x8*)(uintptr_t)(unsigned)(qlds + (s - (ND - QL)) * 1024); } }
            SBAR();
        }
    }
}
__device__ __forceinline__ float bf16_rne(float x) { return __uint_as_float(cvt_pk_bf16(x, 0.f) << 16); }
__device__ __forceinline__ void partialSM_ps(f32x16& p0, f32x16& p1, float& m_off, float& alpha, bf16x8& qx, int hi, bool first) {
    float pmax = p0[0];
#pragma unroll
    for (int r = 1; r < 16; ++r) pmax = fmaxf(pmax, p0[r]);
#pragma unroll
    for (int r = 0; r < 16; ++r) pmax = fmaxf(pmax, p1[r]);
    { auto rr = __builtin_amdgcn_permlane32_swap(__float_as_uint(pmax), __float_as_uint(pmax), false, false);
      pmax = fmaxf(__uint_as_float(rr[0]), __uint_as_float(rr[1])); }
    if (__builtin_expect(!first && __all(pmax <= THR * LOG2E), 1)) { alpha = 1.f; }
    else {
        const float d = first ? pmax : fmaxf(pmax, 0.f);
        const float m_new = bf16_rne(m_off + d), delta = m_new - m_off;
        alpha = first ? 1.f : __builtin_amdgcn_exp2f(-delta); m_off = m_new;
#pragma unroll
        for (int r = 0; r < 16; ++r) { p0[r] -= delta; p1[r] -= delta; }
        const unsigned nb = (hi == 0) ? (cvt_pk_bf16(-m_new, 0.f) & 0xffffu) : 0u;
        u32x4 w = {nb, 0u, 0u, 0u}; qx = *reinterpret_cast<bf16x8*>(&w);
    }
#pragma unroll
    for (int r = 0; r < 16; ++r) p0[r] = __builtin_amdgcn_exp2f(p0[r]);
}
__device__ __forceinline__ void qk_offset_step(f32x16& p0, f32x16& p1, bf16x8 onesf, bf16x8 qx) {
    p0 = __builtin_amdgcn_mfma_f32_32x32x16_bf16(onesf, qx, p0, 0, 0, 0);
    p1 = __builtin_amdgcn_mfma_f32_32x32x16_bf16(onesf, qx, p1, 0, 0, 0);
}
__device__ __forceinline__ int v_st(int k, int c) { const int kk = (k & ~0xC) | ((k & 4) << 1) | ((k & 8) >> 1); return ((kk >> 3) * 4 + (c >> 5)) * 512 + ((kk & 7) * 32 + (c & 31)) * 2; }
__device__ __forceinline__ int v_rd_base(int lane) { return ((lane & 3) << 3) | (((lane >> 2) & 3) << 6) | (((lane >> 4) & 1) << 5) | (((lane >> 5) & 1) << 8); }
constexpr int v_rd_off(int d0, int ks, int half) { return d0 * 512 + ks * 4096 + half * 2048; }
template <int OFF> __device__ __forceinline__ s16x4 tr_read(int vb) {
    s16x4 r; asm volatile("ds_read_b64_tr_b16 %0, %1 offset:%2" : "=&v"(r) : "v"(vb), "i"(OFF) : "memory"); return r;
}
template <int D0> __device__ __forceinline__ void pv_one(f32x16& od, int vb, bf16x8 pa0, bf16x8 pa1, bf16x8 pa2, bf16x8 pa3) {
    const s16x4 l0 = tr_read<v_rd_off(D0, 0, 0)>(vb), h0 = tr_read<v_rd_off(D0, 0, 1)>(vb), l1 = tr_read<v_rd_off(D0, 1, 0)>(vb), h1 = tr_read<v_rd_off(D0, 1, 1)>(vb);
    const s16x4 l2 = tr_read<v_rd_off(D0, 2, 0)>(vb), h2 = tr_read<v_rd_off(D0, 2, 1)>(vb), l3 = tr_read<v_rd_off(D0, 3, 0)>(vb), h3 = tr_read<v_rd_off(D0, 3, 1)>(vb);
    asm volatile("s_waitcnt lgkmcnt(0)" ::: "memory"); SBAR();
#define PK(L, H) (bf16x8){L[0], L[1], L[2], L[3], H[0], H[1], H[2], H[3]}
    od = __builtin_amdgcn_mfma_f32_32x32x16_bf16(pa0, PK(l0, h0), od, 0, 0, 0);
    od = __builtin_amdgcn_mfma_f32_32x32x16_bf16(pa1, PK(l1, h1), od, 0, 0, 0);
    od = __builtin_amdgcn_mfma_f32_32x32x16_bf16(pa2, PK(l2, h2), od, 0, 0, 0);
    od = __builtin_amdgcn_mfma_f32_32x32x16_bf16(pa3, PK(l3, h3), od, 0, 0, 0);
#undef PK
}
__device__ __forceinline__ void pv_d0(f32x16* o, int vb, bf16x8 pa0, bf16x8 pa1, bf16x8 pa2, bf16x8 pa3) {
    pv_one<0>(o[0], vb, pa0, pa1, pa2, pa3); pv_one<1>(o[1], vb, pa0, pa1, pa2, pa3); pv_one<2>(o[2], vb, pa0, pa1, pa2, pa3); pv_one<3>(o[3], vb, pa0, pa1, pa2, pa3);
}

template <int DK, int SD, int QL, bool PS, int PF>
__device__ __forceinline__ void dense_body(const bf16_t* __restrict__ Qb, int ldq, const bf16_t* __restrict__ Kh, int ldk, const bf16_t* __restrict__ KPh,
                                           const bf16_t* __restrict__ Vh, int ldv, bf16_t* __restrict__ Ob, int ldo,
                                           int base0, int n0, int base1, int NT, LAS char* lds) {
    constexpr int SHM_V = 64 * 128 * 2, SHM_K = 64 * DK * 2, ND = DK / 16;
    int tid = threadIdx.x; asm volatile("" : "+v"(tid));
    const int wid = tid >> 6, lane = tid & 63, r32 = lane & 31, hi = lane >> 5;
    LAS char* V_lds = lds; LAS char* K_lds = lds + 2 * SHM_V;
    LAS float* ws = (LAS float*)(lds + 2 * SHM_V + 2 * SHM_K) + wid * 64; LAS float* li_l = ws; LAS float* al_l = ws + 32;
    float m_reg = -1e30f, l_reg = 0; f32x16 o[4] = {}; bf16x8 qr[ND - QL];
    const bf16_t* Qw = Qb + (long)(wid * 32 + r32) * ldq + hi * 8;
#pragma unroll
    for (int d0 = 0; d0 < ND - QL; ++d0) qr[d0] = *(const bf16x8*)(Qw + d0 * 16);
    const int qlds = (int)(unsigned)(uintptr_t)(lds + 2 * SHM_V + 2 * SHM_K + 2048) + wid * (QL * 1024) + lane * 16;
    if constexpr (QL > 0) {
#pragma unroll
        for (int d0 = ND - QL; d0 < ND; ++d0) *(LAS bf16x8*)(uintptr_t)(unsigned)(qlds + (d0 - (ND - QL)) * 1024) = *(const bf16x8*)(Qw + d0 * 16);
    }
    const int sr = tid >> 4, sc = (tid & 15) * 8, vst0 = v_st(sr, sc), vst1 = v_st(32 + sr, sc);
    const int pr = tid >> 3, pc = (tid & 7) * 8;
    const int kst0 = kswz<DK>(sr, sc * 2), kst1 = kswz<DK>(32 + sr, sc * 2), kstp = kswz<DK>(pr, 256 + pc * 2);
    const int vb0 = (int)(unsigned)(uintptr_t)V_lds + v_rd_base(lane);
    bf16x8 vs0, vs1, ks0, ks1, kp;
#define TROW(j) ((long)((j) < n0 ? base0 + (j) * 64 : base1 + ((j) - n0) * 64))
#define LOADK(j) do { const long r0_ = TROW(j); ks0 = *(const bf16x8*)(&Kh[(r0_ + sr) * ldk + sc]); ks1 = *(const bf16x8*)(&Kh[(r0_ + 32 + sr) * ldk + sc]); \
    if constexpr (DK == 192) kp = *(const bf16x8*)(&KPh[(r0_ + pr) * 64 + pc]); } while (0)
#define LOADV(j) do { const long r0_ = TROW(j); vs0 = *(const bf16x8*)(&Vh[(r0_ + sr) * ldv + sc]); vs1 = *(const bf16x8*)(&Vh[(r0_ + 32 + sr) * ldv + sc]); } while (0)
#define WRITEK(b) do { *(LAS bf16x8*)(K_lds + (b) * SHM_K + kst0) = ks0; *(LAS bf16x8*)(K_lds + (b) * SHM_K + kst1) = ks1; \
    if constexpr (DK == 192) *(LAS bf16x8*)(K_lds + (b) * SHM_K + kstp) = kp; } while (0)
#define WRITEV(b) do { *(LAS bf16x8*)(V_lds + (b) * SHM_V + vst0) = vs0; *(LAS bf16x8*)(V_lds + (b) * SHM_V + vst1) = vs1; } while (0)
#define VMW0() asm volatile("s_waitcnt vmcnt(0)" ::: "memory")
#define RESC(a) do { if (__any((a) < 1.f)) { if (hi == 0) al_l[r32] = (a); asm volatile("s_waitcnt lgkmcnt(0)" ::: "memory"); \
    _Pragma("unroll") for (int d = 0; d < 4; ++d) _Pragma("unroll") for (int r = 0; r < 16; ++r) o[d][r] *= al_l[crow(r, hi)]; } } while (0)
    f32x16 pA0, pA1, pB0, pB1; float mnA, mnB, alA, alB; bf16x8 pa0, pa1, pa2, pa3;
    bf16x8 qx = {0, 0, 0, 0, 0, 0, 0, 0}, onesf = {0, 0, 0, 0, 0, 0, 0, 0}; float m_off = 0.f;
    if constexpr (PS) { if (hi == 0) onesf[0] = (short)0x3F80; }
    (void)mnA; (void)mnB;
#define SCORES(P0, P1, KB) do { qkt<DK, QL, PF>(P0, P1, KB, qr, r32, hi, qlds); if constexpr (PS) qk_offset_step(P0, P1, onesf, qx); } while (0)
#define PSM(P0, P1, mnC, alC, FIRST) do { if constexpr (PS) partialSM_ps(P0, P1, m_off, alC, qx, hi, FIRST); else partialSM<DK>(P0, P1, m_reg, mnC, alC); } while (0)
#define ITER(j, PAR, PC0, PC1, mnC, alC, PP0, PP1, alP) do { \
    __syncthreads(); VMW0(); \
    if ((j) + 1 < NT) WRITEK(1 - (PAR)); \
    WRITEV(PAR); \
    SBAR(); SCORES(PC0, PC1, K_lds + (PAR) * SHM_K); \
    finishSM(PP0, PP1, alP, l_reg, pa0, pa1, pa2, pa3); SBAR(); \
    if ((j) + 2 < NT) LOADK((j) + 2); \
    if ((j) + 1 < NT) LOADV((j) + 1); \
    SBAR(); \
    pv_d0(o, vb0 + (1 - (PAR)) * SHM_V, pa0, pa1, pa2, pa3); PSM(PC0, PC1, mnC, alC, false); \
    RESC(alC); } while (0)
    LOADK(0); VMW0(); WRITEK(0);
    LOADK(1); LOADV(0); VMW0(); WRITEK(1); WRITEV(0);
    if (2 < NT) LOADK(2);
    LOADV(1);
    __syncthreads();
    SCORES(pA0, pA1, K_lds); PSM(pA0, pA1, mnA, alA, true);
    int j = 1;
    for (; j + 2 <= NT - 1; j += 2) {
        ITER(j, 1, pB0, pB1, mnB, alB, pA0, pA1, alA);
        ITER(j + 1, 0, pA0, pA1, mnA, alA, pB0, pB1, alB);
    }
    ITER(j, 1, pB0, pB1, mnB, alB, pA0, pA1, alA);
    __syncthreads();
    finishSM(pB0, pB1, alB, l_reg, pa0, pa1, pa2, pa3); SBAR();
    pv_d0(o, vb0 + SHM_V, pa0, pa1, pa2, pa3);
    if (hi == 0) li_l[r32] = l_reg; asm volatile("s_waitcnt lgkmcnt(0)" ::: "memory");
    float rli[16];
#pragma unroll
    for (int r = 0; r < 16; ++r) rli[r] = __builtin_amdgcn_rcpf(li_l[crow(r, hi)]);
    bf16_t* Ow = Ob + (long)(wid * 32) * ldo;
#pragma unroll
    for (int r = 0; r < 16; ++r) { const int orow = crow(r, hi);
#pragma unroll
        for (int d0 = 0; d0 < 4; ++d0) Ow[(long)orow * ldo + d0 * 32 + r32] = f2bf(o[d0][r] * rli[r]); }
    asm volatile("s_waitcnt vmcnt(0) lgkmcnt(0)" ::: "memory");
    __syncthreads();
#undef TROW
#undef LOADK
#undef LOADV
#undef WRITEK
#undef WRITEV
#undef VMW0
#undef ITER
#undef SCORES
#undef PSM
}

__device__ __forceinline__ void na_body(const bf16_t* __restrict__ QKV, int b, int rg, int h, const float* __restrict__ rpb_h, bf16_t* __restrict__ O, LAS char* lds, LAS float* tab) {
    constexpr int SHM = 16384, LD = 6144; constexpr float C = 0.088388347648318440f * LOG2E;
    int tid = threadIdx.x; asm volatile("" : "+v"(tid));
    const int wid = tid >> 6, lane = tid & 63, r32 = lane & 31, hi = lane >> 5;
    LAS char* V_lds = lds; LAS char* K_lds = lds + SHM;
    LAS float* ws = (LAS float*)(lds + 2 * SHM) + wid * 64; LAS float* li_l = ws; LAS float* al_l = ws + 32;
    for (int i = tid; i < 465; i += 512) tab[48 + i] = rpb_h[i] * LOG2E;
    const int qrow = 4 * rg + (wid >> 1), qc = (wid & 1) * 32 + r32;
    const int rs = min(max(qrow - 4, 0), 248), cs = min(max(qc - 8, 0), 48);
    const int R0 = min(max(4 * rg - 4, 0), 248), R1 = min(max(4 * rg - 1, 0), 248) + 8, nrt = R1 - R0, NT = nrt + 4;
    float m_reg = -1e30f, l_reg = 0; f32x16 o[4] = {}; bf16x8 qr[8];
    const bf16_t* Qw = QKV + ((long)b * SEQ + qrow * 64 + qc) * LD + h * 128 + hi * 8;
#pragma unroll
    for (int d0 = 0; d0 < 8; ++d0) qr[d0] = *(const bf16x8*)(Qw + d0 * 16);
    const bf16_t* Kh = QKV + 2048 + h * 128; const bf16_t* Vh = QKV + 4096 + h * 128;
    const int sr = tid >> 4, sc = (tid & 15) * 8, vst0 = v_st(sr, sc), vst1 = v_st(32 + sr, sc);
    const int kst0 = kswz<128>(sr, sc * 2), kst1 = kswz<128>(32 + sr, sc * 2);
    const int vb0 = (int)(unsigned)(uintptr_t)V_lds + v_rd_base(lane);
    bf16x8 vs0, vs1, ks0, ks1;
#define TROW(j) ((long)((j) < nrt ? b * SEQ + (R0 + (j)) * 64 : NLAT + b * CTXL + ((j) - nrt) * 64))
#define SLOAD(j) do { const long r0_ = TROW(j); vs0 = *(const bf16x8*)(&Vh[(r0_ + sr) * LD + sc]); vs1 = *(const bf16x8*)(&Vh[(r0_ + 32 + sr) * LD + sc]); \
    ks0 = *(const bf16x8*)(&Kh[(r0_ + sr) * LD + sc]); ks1 = *(const bf16x8*)(&Kh[(r0_ + 32 + sr) * LD + sc]); } while (0)
    SLOAD(0);
    for (int j = 0; j < NT; ++j) {
        asm volatile("s_waitcnt vmcnt(0)" ::: "memory");
        __syncthreads();
        *(LAS bf16x8*)(V_lds + vst0) = vs0; *(LAS bf16x8*)(V_lds + vst1) = vs1; *(LAS bf16x8*)(K_lds + kst0) = ks0; *(LAS bf16x8*)(K_lds + kst1) = ks1;
        __syncthreads();
        if (j + 1 < NT) SLOAD(j + 1);
        const bool isctx = j >= nrt; const int krow = R0 + j;
        if (isctx || (krow >= rs && krow < rs + 8)) {
            f32x16 p0, p1;
            qkt<128>(p0, p1, K_lds, qr, r32, hi);
            if (!isctx) {
                const int dr = krow - qrow + 7;
                const LAS float* tb = tab + 48 + dr * 31 + 15 - qc + 4 * hi;
#pragma unroll
                for (int r = 0; r < 16; ++r) { const int c0 = (r & 3) + 8 * (r >> 2); const int kc0 = c0 + 4 * hi, kc1 = kc0 + 32;
                    const float b0 = tb[c0], b1 = tb[c0 + 32];
                    p0[r] = (kc0 >= cs && kc0 < cs + 16) ? fmaf(p0[r], C, b0) : -1e30f;
                    p1[r] = (kc1 >= cs && kc1 < cs + 16) ? fmaf(p1[r], C, b1) : -1e30f; }
            } else {
#pragma unroll
                for (int r = 0; r < 16; ++r) { p0[r] *= C; p1[r] *= C; }
            }
            float pmax = p0[0];
#pragma unroll
            for (int r = 1; r < 16; ++r) pmax = fmaxf(pmax, p0[r]);
#pragma unroll
            for (int r = 0; r < 16; ++r) pmax = fmaxf(pmax, p1[r]);
            { auto rr = __builtin_amdgcn_permlane32_swap(__float_as_uint(pmax), __float_as_uint(pmax), false, false);
              pmax = fmaxf(__uint_as_float(rr[0]), __uint_as_float(rr[1])); }
            float mn, alpha;
            if (__all(pmax - m_reg <= THR * LOG2E)) { mn = m_reg; alpha = 1.f; }
            else { mn = fmaxf(m_reg, pmax); alpha = __builtin_amdgcn_exp2f(m_reg - mn); m_reg = mn; }
#pragma unroll
            for (int r = 0; r < 16; ++r) { p0[r] = __builtin_amdgcn_exp2f(p0[r] - mn); p1[r] = __builtin_amdgcn_exp2f(p1[r] - mn); }
            bf16x8 pa0, pa1, pa2, pa3;
            float ps = 0;
#pragma unroll
            for (int r = 0; r < 16; ++r) ps += p0[r] + p1[r];
            { auto rr = __builtin_amdgcn_permlane32_swap(__float_as_uint(ps), __float_as_uint(ps), false, false);
              ps = __uint_as_float(rr[0]) + __uint_as_float(rr[1]); }
            l_reg = l_reg * alpha + ps;
#define PK4(P, BASE, OUT) do { unsigned a0 = cvt_pk_bf16(P[BASE + 0], P[BASE + 1]), a1 = cvt_pk_bf16(P[BASE + 2], P[BASE + 3]);   \
    unsigned b0 = cvt_pk_bf16(P[BASE + 4], P[BASE + 5]), b1 = cvt_pk_bf16(P[BASE + 6], P[BASE + 7]);                              \
    auto r0 = __builtin_amdgcn_permlane32_swap(a0, b0, false, false); auto r1 = __builtin_amdgcn_permlane32_swap(a1, b1, false, false); \
    u32x4 w = {r0[0], r1[0], r0[1], r1[1]}; OUT = *reinterpret_cast<bf16x8*>(&w); } while (0)
            PK4(p0, 0, pa0); PK4(p0, 8, pa1); PK4(p1, 0, pa2); PK4(p1, 8, pa3);
#undef PK4
            RESC(alpha);
            pv_d0(o, vb0, pa0, pa1, pa2, pa3);
        }
    }
    if (hi == 0) li_l[r32] = l_reg; asm volatile("s_waitcnt lgkmcnt(0)" ::: "memory");
    float rli[16];
#pragma unroll
    for (int r = 0; r < 16; ++r) rli[r] = __builtin_amdgcn_rcpf(li_l[crow(r, hi)]);
    bf16_t* Ow = O + ((long)b * SEQ + qrow * 64 + (wid & 1) * 32) * DM + h * 128;
#pragma unroll
    for (int r = 0; r < 16; ++r) { const int orow = crow(r, hi);
#pragma unroll
        for (int d0 = 0; d0 < 4; ++d0) Ow[(long)orow * DM + d0 * 32 + r32] = f2bf(o[d0][r] * rli[r]); }
    asm volatile("s_waitcnt vmcnt(0) lgkmcnt(0)" ::: "memory");
    __syncthreads();
#undef TROW
#undef SLOAD
}
#undef RESC
}

#define XB_TMO      128
#define XB_XCNT(j)  (256  + 64 * (j))
#define XB_XSUB(j)  (1280 + 64 * (j))
#define XB_XGEN(j)  (2304 + 64 * (j))
#define XB_TOP      3328
#define XB_TOPGEN   3392
#define XCD_BAR_WORDS 3456
#define XB_SPIN_CAP (1u << 22)
__device__ __forceinline__ unsigned xb_ld(unsigned* p)              { return __hip_atomic_load(p, __ATOMIC_RELAXED, __HIP_MEMORY_SCOPE_AGENT); }
__device__ __forceinline__ unsigned xb_add(unsigned* p, unsigned v) { return __hip_atomic_fetch_add(p, v, __ATOMIC_RELAXED, __HIP_MEMORY_SCOPE_AGENT); }
__device__ __forceinline__ unsigned xb_xcc_id() { return (unsigned)__builtin_amdgcn_s_getreg((3 << 11) | 20) & 0xFu; }
#define XB_SPIN(cond, bar) do { unsigned _sp = 0; while (cond) { __builtin_amdgcn_s_sleep(1); \
    if ((++_sp & 255u) == 0u) { if (xb_ld(&(bar)[XB_TMO])) break; if (_sp > XB_SPIN_CAP) { atomicAdd(&(bar)[XB_TMO], 1u); break; } } } } while (0)
struct XcdBarrier { unsigned* bar; unsigned x; volatile LAS unsigned* st; };
__device__ __forceinline__ XcdBarrier xcd_barrier_post(unsigned* bar, volatile LAS unsigned* st) {
    XcdBarrier b; b.bar = bar; b.x = xb_xcc_id(); b.st = st;
    if (threadIdx.x == 0) (void)xb_add(&bar[XB_XCNT(b.x)], 1u);
    return b;
}
__device__ __forceinline__ void xcd_barrier_complete(unsigned* bar, unsigned x, unsigned& nloc, unsigned& nx) {
    const unsigned G = gridDim.x * gridDim.y * gridDim.z;
    unsigned sum, cnt, mine, sp = 0u;
    for (;;) {
        sum = 0u; cnt = 0u; mine = 0u;
#pragma unroll
        for (unsigned j = 0; j < 16; ++j) { const unsigned c = xb_ld(&bar[XB_XCNT(j)]); sum += c; cnt += (c > 0u) ? 1u : 0u; mine = (j == x) ? c : mine; }
        if (sum == G) break;
        __builtin_amdgcn_s_sleep(1);
        if ((++sp & 255u) == 0u) { if (xb_ld(&bar[XB_TMO])) break; if (sp > XB_SPIN_CAP) { atomicAdd(&bar[XB_TMO], 1u); break; } }
    }
    nloc = mine > 0u ? mine : 1u; nx = cnt > 0u ? cnt : 1u;
}
__device__ __forceinline__ void xcd_barrier(const XcdBarrier& b) {
    asm volatile("s_waitcnt vmcnt(0)" ::: "memory");
    __syncthreads();
    if (threadIdx.x == 0) {
        unsigned* bar = b.bar;
        __builtin_amdgcn_s_waitcnt(0);
        unsigned nloc = b.st[0], nx = b.st[1];
        if (nloc == 0u) { xcd_barrier_complete(bar, b.x, nloc, nx); b.st[0] = nloc; b.st[1] = nx; }
        const unsigned old = xb_add(&bar[XB_XSUB(b.x)], 1u);
        const unsigned gen = old / nloc;
        if (old + 1u == (gen + 1u) * nloc) {
            __builtin_amdgcn_fence(__ATOMIC_RELEASE, "agent");
            asm volatile("s_waitcnt vmcnt(0)" ::: "memory");
            const unsigned og = xb_add(&bar[XB_TOP], 1u);
            const unsigned tg = og / nx;
            if (og + 1u == (tg + 1u) * nx) xb_add(&bar[XB_TOPGEN], 1u);
            else XB_SPIN(xb_ld(&bar[XB_TOPGEN]) == tg, bar);
            __builtin_amdgcn_fence(__ATOMIC_ACQUIRE, "agent");
            xb_add(&bar[XB_XGEN(b.x)], 1u);
            asm volatile("s_waitcnt vmcnt(0)" ::: "memory");
        } else {
            XB_SPIN(xb_ld(&bar[XB_XGEN(b.x)]) == gen, bar);
            __builtin_amdgcn_fence(__ATOMIC_ACQUIRE, "agent");
            asm volatile("s_waitcnt vmcnt(0)" ::: "memory");
        }
    }
    __syncthreads();
}

constexpr int NIN = 27;
struct Args { const float* in[NIN]; float* out; unsigned char* ws; int ph_lo, ph_hi; unsigned rep_mask, pad; };
struct Frame {
    LAS unsigned char* lds; int tid, lane, wave, vcu, G, gw, NGW;
    unsigned char* ws; float* X; bf16_t* H; bf16_t* O; unsigned char* big; unsigned char* wts; float* mods; float* tab; float* rs;
};
constexpr int PPL = 11;
constexpr int NPH = 1 + DEPTH * PPL + 1;
__host__ __device__ inline bool phase_exists(int ph) {
    if (ph == 0 || ph == NPH - 1) return true;
    const int l = (ph - 1) / PPL, j = (ph - 1) % PPL, kind = l % 3;
    if (j == 2) return kind != 0;
    if (j == 3 || j == 4) return kind == 1;
    return true;
}

__device__ __forceinline__ void transpose_item(const float* W, int K, int N, bf16_t* WT, int mode, int row_off, const float* ks, LAS float* scr, int item, int lane) {
    const int nblk = N / 32, kb = item / nblk, nb = item % nblk, k0 = 64 * kb, n0 = 32 * nb;
#pragma unroll 8
    for (int i = 0; i < 32; ++i) { const int kk = 2 * i + (lane >> 5); float v = W[(size_t)(k0 + kk) * N + n0 + (lane & 31)]; if (ks) v *= ks[k0 + kk]; scr[kk * 33 + (lane & 31)] = v; }
    asm volatile("s_waitcnt lgkmcnt(0)" ::: "memory");
    const int c = lane & 7;
#pragma unroll
    for (int j = 0; j < 4; ++j) { const int n = (lane >> 3) + 8 * j; const LAS float* s = scr + (8 * c) * 33 + n;
        u32x4 o; o.x = cvt_pk_bf16(s[0 * 33], s[1 * 33]); o.y = cvt_pk_bf16(s[2 * 33], s[3 * 33]); o.z = cvt_pk_bf16(s[4 * 33], s[5 * 33]); o.w = cvt_pk_bf16(s[6 * 33], s[7 * 33]);
        const int nn = n0 + n; int drow;
        if (mode == 1) { if (nn < FFD) drow = (nn >> 7) * 256 + (nn & 127); else { const int ch = nn - FFD; drow = (ch >> 7) * 256 + 128 + (ch & 127); } }
        else drow = row_off + nn;
        *(u32x4*)(WT + (size_t)drow * K + k0 + 8 * c) = o; }
    asm volatile("s_waitcnt lgkmcnt(0)" ::: "memory");
}

typedef const __attribute__((address_space(4))) Args* KArgs;
__device__ __forceinline__ void prologue_phase(Frame& F, KArgs a) {
    LAS float* sil = (LAS float*)F.lds;
    for (int i = F.tid; i < 3 * DM; i += 512) { const int j = i / DM, k = i % DM; const float c = (j < 2) ? a->in[1][j * DM + k] : a->in[3][k]; sil[i] = silu_f(c); }
    __syncthreads();
    for (int task = F.gw; task < DEPTH * (MODW / 32); task += F.NGW) {
        const int l = task / (MODW / 32), n0 = (task % (MODW / 32)) * 32, col = n0 + (F.lane & 31), kp = F.lane >> 5;
        const float* w = a->in[4] + (size_t)l * DM * MODW + col;
        float a0 = 0.f, a1 = 0.f, a2 = 0.f;
#pragma unroll 8
        for (int k = kp; k < DM; k += 2) { const float wv = w[(size_t)k * MODW]; a0 = fmaf(sil[k], wv, a0); a1 = fmaf(sil[DM + k], wv, a1); a2 = fmaf(sil[2 * DM + k], wv, a2); }
        a0 += __shfl_xor(a0, 32); a1 += __shfl_xor(a1, 32); a2 += __shfl_xor(a2, 32);
        if (kp == 0) { const float bv = a->in[5][l * MODW + col]; float* m = F.mods + (size_t)l * 3 * MODW + col; m[0] = a0 + bv; m[MODW] = a1 + bv; m[2 * MODW] = a2 + bv; }
    }
    if (blockIdx.x == 0) {
        for (int i = F.tid; i < 256 * 16 + 256 * 32; i += 512) {
            int pos, ii, quarter; float* cdst; float* sdst;
            if (i < 256 * 16) { pos = i / 16; ii = i % 16; quarter = 16; cdst = F.tab + i; sdst = F.tab + 4096 + i; }
            else { const int k = i - 256 * 16; pos = k / 32; ii = k % 32; quarter = 32; cdst = F.tab + 8192 + k; sdst = F.tab + 16384 + k; }
            const float inv = exp2f(-13.287712379549449f * (float)ii / (float)quarter);
            const float ang = (float)pos * inv;
            const double rev = (double)ang * 0.15915494309189535; const double fr = rev - floor(rev);
            *cdst = __builtin_amdgcn_cosf((float)fr); *sdst = __builtin_amdgcn_sinf((float)fr);
        }
    }
    LAS float* scr = (LAS float*)(F.lds + 32768 + F.wave * 8704);
    {
        constexpr int I_UP = (DM / 64) * (2 * FFD / 32), I_DN = (FFD / 64) * (DM / 32), I_NQ = (DM / 64) * (3 * DM / 32), I_NO = (DM / 64) * (DM / 32);
        constexpr int I_MQA = (DM / 64) * (512 / 32), I_MKA = (DM / 64) * (576 / 32), I_MQB = (512 / 64) * (3072 / 32), I_MKB = (512 / 64) * (4096 / 32), I_MO = I_NO;
        constexpr int I_GQ = (DM / 64) * (3072 / 32), I_GO = I_NO;
        constexpr int NITEMS = 4 * I_UP + 4 * I_DN + 2 * I_NQ + 2 * I_NO + I_MQA + I_MKA + I_MQB + I_MKB + I_MO + I_GQ + I_GO;
        bf16_t* wt = (bf16_t*)F.wts;
        for (int it = F.gw; it < NITEMS; it += F.NGW) {
            int r = it;
            if (r < 4 * I_UP) { const int l = r / I_UP; transpose_item(a->in[8] + (size_t)l * DM * 2 * FFD, DM, 2 * FFD, (bf16_t*)(F.wts + W_UP + l * W_UP_L), 1, 0, nullptr, scr, r % I_UP, F.lane); continue; } r -= 4 * I_UP;
            if (r < 4 * I_DN) { const int l = r / I_DN; transpose_item(a->in[11] + (size_t)l * FFD * DM, FFD, DM, (bf16_t*)(F.wts + W_DN + l * W_DN_L), 0, 0, nullptr, scr, r % I_DN, F.lane); continue; } r -= 4 * I_DN;
            if (r < 2 * I_NQ) { const int l = r / I_NQ; transpose_item(a->in[12] + (size_t)l * DM * 3 * DM, DM, 3 * DM, (bf16_t*)(F.wts + W_NAQKV + l * W_NAQKV_L), 0, 0, nullptr, scr, r % I_NQ, F.lane); continue; } r -= 2 * I_NQ;
            if (r < 2 * I_NO) { const int l = r / I_NO; transpose_item(a->in[14] + (size_t)l * DM * DM, DM, DM, (bf16_t*)(F.wts + W_NAWO + l * W_NAWO_L), 0, 0, nullptr, scr, r % I_NO, F.lane); continue; } r -= 2 * I_NO;
            if (r < I_MQA) { transpose_item(a->in[15], DM, 512, (bf16_t*)(F.wts + W_MLA1), 0, 0, nullptr, scr, r, F.lane); continue; } r -= I_MQA;
            if (r < I_MKA) { transpose_item(a->in[18], DM, 576, (bf16_t*)(F.wts + W_MLA1), 0, 512, nullptr, scr, r, F.lane); continue; } r -= I_MKA;
            if (r < I_MQB) { transpose_item(a->in[17], 512, 3072, (bf16_t*)(F.wts + W_MLAQB), 0, 0, a->in[16], scr, r, F.lane); continue; } r -= I_MQB;
            if (r < I_MKB) { transpose_item(a->in[20], 512, 4096, (bf16_t*)(F.wts + W_MLAKVB), 0, 0, a->in[19], scr, r, F.lane); continue; } r -= I_MKB;
            if (r < I_MO) { transpose_item(a->in[21], DM, DM, (bf16_t*)(F.wts + W_MLAWO), 0, 0, nullptr, scr, r, F.lane); continue; } r -= I_MO;
            if (r < I_GQ) { transpose_item(a->in[22], DM, 3072, (bf16_t*)(F.wts + W_GQAQKV), 0, 0, nullptr, scr, r, F.lane); continue; } r -= I_GQ;
            transpose_item(a->in[25], DM, DM, (bf16_t*)(F.wts + W_GQAWO), 0, 0, nullptr, scr, r, F.lane);
        }
        (void)wt;
        u32x4* z = (u32x4*)(F.wts + W_MLA1 + (size_t)1088 * DM * 2);
        const u32x4 zero = {0u, 0u, 0u, 0u};
        for (int i = blockIdx.x * 512 + F.tid; i < 192 * DM * 2 / 16; i += F.G * 512) z[i] = zero;
    }
}

__device__ __forceinline__ void norm_phase(Frame& F, const float* gain, const float* mods_l, int sh_off, int sc_off, int nrows, const float* pgate, int pks, const float* lat_src, const float* ctx_src) {
    for (int row = F.gw; row < nrows; row += F.NGW) {
        const float* m = mods_l + (size_t)row_midx(row) * MODW;
        f32x4* xr = (f32x4*)(F.X + (size_t)row * DM) + F.lane;
        const f32x4* xs = (const f32x4*)(row < NLAT ? lat_src + (size_t)row * DM : ctx_src + (size_t)(row - NLAT) * DM) + F.lane;
        f32x4 v[8]; float s = 0.f;
#pragma unroll
        for (int j = 0; j < 8; ++j) v[j] = xs[64 * j];
        if (pgate != nullptr && row >= NLAT) {
            const f32x4* pr = (const f32x4*)((const float*)(F.ws + WS_PART) + (size_t)(row - NLAT) * DM) + F.lane;
            f32x4 a[8];
#pragma unroll
            for (int j = 0; j < 8; ++j) a[j] = (f32x4){0.f, 0.f, 0.f, 0.f};
            for (int kc = 0; kc < pks; kc += 2) {
                f32x4 t0[8], t1[8];
#pragma unroll
                for (int j = 0; j < 8; ++j) { t0[j] = pr[(size_t)kc * (NBATCH * CTXL) * (DM / 4) + 64 * j]; t1[j] = pr[(size_t)(kc + 1) * (NBATCH * CTXL) * (DM / 4) + 64 * j]; }
#pragma unroll
                for (int j = 0; j < 8; ++j) a[j] += t0[j] + t1[j];
            }
#pragma unroll
            for (int j = 0; j < 8; ++j) { v[j] += *(const f32x4*)(pgate + (F.lane + 64 * j) * 4) * a[j]; xr[64 * j] = v[j]; }
        }
#pragma unroll
        for (int j = 0; j < 8; ++j) s += (v[j].x * v[j].x + v[j].y * v[j].y) + (v[j].z * v[j].z + v[j].w * v[j].w);
        const float rstd = rsqrtf(wave_sum(s) * (1.f / DM) + NORM_EPS);
        u32x2* o8 = (u32x2*)(F.H + (size_t)row * DM) + F.lane;
#pragma unroll
        for (int j = 0; j < 8; ++j) { const int col = (F.lane + 64 * j) * 4;
            const f32x4 g = *(const f32x4*)(gain + col), sc = *(const f32x4*)(m + sc_off + col), sh = *(const f32x4*)(m + sh_off + col);
            const f32x4 y = (v[j] * rstd) * g * (sc + 1.0f) + sh;
            u32x2 w; w.x = cvt_pk_bf16(y.x, y.y); w.y = cvt_pk_bf16(y.z, y.w); o8[64 * j] = w; }
    }
}
__device__ __forceinline__ void final_phase(Frame& F, const float* gain, float* out) {
    for (int row = F.gw; row < NLAT; row += F.NGW) {
        const f32x4* xr = (const f32x4*)(F.X + (size_t)row * DM) + F.lane;
        f32x4 v[8]; float s = 0.f;
#pragma unroll
        for (int j = 0; j < 8; ++j) { v[j] = xr[64 * j]; s += (v[j].x * v[j].x + v[j].y * v[j].y) + (v[j].z * v[j].z + v[j].w * v[j].w); }
        const float rstd = rsqrtf(wave_sum(s) * (1.f / DM) + NORM_EPS);
        f32x4* o = (f32x4*)(out + (size_t)row * DM) + F.lane;
#pragma unroll
        for (int j = 0; j < 8; ++j) { const int col = (F.lane + 64 * j) * 4; o[64 * j] = (v[j] * rstd) * *(const f32x4*)(gain + col); }
    }
}
__device__ __forceinline__ void mla_post1_phase(Frame& F) {
    const bf16_t* T1 = (const bf16_t*)(F.big + BIG_T1); bf16_t* KPE = (bf16_t*)(F.big + BIG_KPE);
    const float* tc = F.tab; const float* ts = F.tab + 4096;
    for (int row = F.gw; row < MROWS; row += F.NGW) {
        const bf16_t* t = T1 + (size_t)row * 1280;
        const u32x4 qa = *(const u32x4*)(t + F.lane * 8), ka = *(const u32x4*)(t + 512 + F.lane * 8);
        float sa = 0.f, sb = 0.f;
#pragma unroll
        for (int j = 0; j < 4; ++j) { const float a0 = bf_lo(qa[j]), a1 = bf_hi(qa[j]), b0 = bf_lo(ka[j]), b1 = bf_hi(ka[j]); sa += a0 * a0 + a1 * a1; sb += b0 * b0 + b1 * b1; }
        sa = wave_sum(sa); sb = wave_sum(sb);
        if (F.lane == 0) { F.rs[(size_t)row * 2] = rsqrtf(sa * (1.f / 512.f) + NORM_EPS); F.rs[(size_t)row * 2 + 1] = rsqrtf(sb * (1.f / 512.f) + NORM_EPS); }
        float x = bf2f(t[1024 + F.lane]);
        const float xp = __shfl_xor(x, 16);
        if (row < NLAT) { const int tok = row & (SEQ - 1); const int pos = (F.lane < 32) ? (tok >> 6) : (tok & 63); const int ii = F.lane & 15;
            const float c = tc[pos * 16 + ii], s = ts[pos * 16 + ii]; x = (F.lane & 16) ? (x * c + xp * s) : (x * c - xp * s); }
        KPE[(size_t)row * 64 + F.lane] = f2bf(x);
    }
}
__device__ __forceinline__ void mla_qrope_phase(Frame& F) {
    bf16_t* Q = (bf16_t*)(F.big + BIG_Q); const float* tc = F.tab; const float* ts = F.tab + 4096;
    for (int row = F.gw; row < NLAT; row += F.NGW) {
        const int tok = row & (SEQ - 1), e4 = (F.lane & 15) * 4, q = e4 >> 4, pos = (q < 2) ? (tok >> 6) : (tok & 63), ii = e4 & 15;
        const f32x4 c = *(const f32x4*)(tc + pos * 16 + ii), s = *(const f32x4*)(ts + pos * 16 + ii);
        const float sg = (q & 1) ? 1.f : -1.f;
        u32x2 w[4];
#pragma unroll
        for (int it = 0; it < 4; ++it) w[it] = *(const u32x2*)(Q + (size_t)row * 3072 + (4 * it + (F.lane >> 4)) * 192 + 128 + e4);
#pragma unroll
        for (int it = 0; it < 4; ++it) {
            u32x2 p; p.x = __shfl_xor(w[it].x, 4); p.y = __shfl_xor(w[it].y, 4);
            const float x0 = bf_lo(w[it].x), x1 = bf_hi(w[it].x), x2 = bf_lo(w[it].y), x3 = bf_hi(w[it].y);
            const float y0 = bf_lo(p.x), y1 = bf_hi(p.x), y2 = bf_lo(p.y), y3 = bf_hi(p.y);
            u32x2 o; o.x = cvt_pk_bf16(x0 * c.x + sg * y0 * s.x, x1 * c.y + sg * y1 * s.y); o.y = cvt_pk_bf16(x2 * c.z + sg * y2 * s.z, x3 * c.w + sg * y3 * s.w);
            *(u32x2*)(Q + (size_t)row * 3072 + (4 * it + (F.lane >> 4)) * 192 + 128 + e4) = o;
        }
    }
}
__device__ __forceinline__ void gqa_post_phase(Frame& F, const float* qn, const float* kn) {
    bf16_t* QKV = (bf16_t*)(F.big + BIG_QKV); const float* tc = F.tab + 8192; const float* ts = F.tab + 16384;
    for (int row = F.gw; row < MROWS; row += F.NGW) {
        const bool lat = row < NLAT; const int tok = row & (SEQ - 1), e4 = (F.lane & 31) * 4, q = e4 >> 5, pos = (q < 2) ? (tok >> 6) : (tok & 63), ii = e4 & 31;
        f32x4 c = {1.f, 1.f, 1.f, 1.f}, s = {0.f, 0.f, 0.f, 0.f};
        if (lat) { c = *(const f32x4*)(tc + pos * 32 + ii); s = *(const f32x4*)(ts + pos * 32 + ii); }
        const float sg = (q & 1) ? 1.f : -1.f;
        const f32x4 gq = *(const f32x4*)(qn + e4), gk = *(const f32x4*)(kn + e4);
#pragma unroll 2
        for (int it = 0; it < 10; ++it) {
            const int hh = 2 * it + (F.lane >> 5);
            bf16_t* p = QKV + (size_t)row * 3072 + hh * 128 + e4;
            const u32x2 w = *(const u32x2*)p;
            float x0 = bf_lo(w.x), x1 = bf_hi(w.x), x2 = bf_lo(w.y), x3 = bf_hi(w.y);
            float ss = x0 * x0 + x1 * x1 + x2 * x2 + x3 * x3;
#pragma unroll
            for (int o = 1; o < 32; o <<= 1) ss += __shfl_xor(ss, o);
            const float rstd = rsqrtf(ss * (1.f / 128.f) + NORM_EPS);
            const f32x4 g = (hh < 16) ? gq : gk;
            x0 = x0 * rstd * g.x; x1 = x1 * rstd * g.y; x2 = x2 * rstd * g.z; x3 = x3 * rstd * g.w;
            const float y0 = __shfl_xor(x0, 8), y1 = __shfl_xor(x1, 8), y2 = __shfl_xor(x2, 8), y3 = __shfl_xor(x3, 8);
            const float qs = (hh < 16) ? (0.088388347648318440f * LOG2E) : 1.0f;
            u32x2 o; o.x = cvt_pk_bf16((x0 * c.x + sg * y0 * s.x) * qs, (x1 * c.y + sg * y1 * s.y) * qs); o.y = cvt_pk_bf16((x2 * c.z + sg * y2 * s.z) * qs, (x3 * c.w + sg * y3 * s.w) * qs);
            *(u32x2*)p = o;
        }
    }
}
__device__ __forceinline__ void ffn_fix_phase(Frame& F, const float* cw, const float* cb, int nblk) {
    bf16_t* ACT = (bf16_t*)(F.big + BIG_ACT); const float* side = (const float*)(F.big + BIG_SIDE);
    const int total = nblk * 2 * (FFD / 4);
    for (int idx = blockIdx.x * 512 + F.tid; idx < total; idx += F.G * 512) {
        const int c4 = idx % (FFD / 4), t = idx / (FFD / 4), which = t & 1, blk = t >> 1, ch = c4 * 4;
        const f32x4 w0 = *(const f32x4*)(cw + ch), w1 = *(const f32x4*)(cw + FFD + ch), w2 = *(const f32x4*)(cw + 2 * FFD + ch), bb = *(const f32x4*)(cb + ch);
        const float* sb = side + (size_t)blk * FFD + ch;
        f32x4 prev, g0, nx, v; int row;
        if (which == 0) { row = blk * 64; const bool st = (row == 0 || row == SEQ || row == NLAT || row == NLAT + CTXL);
            prev = st ? (f32x4){0.f, 0.f, 0.f, 0.f} : *(const f32x4*)(sb - FFD + 3 * SIDE_ARR); g0 = *(const f32x4*)(sb + 0 * SIDE_ARR); nx = *(const f32x4*)(sb + 1 * SIDE_ARR); v = *(const f32x4*)(sb + 4 * SIDE_ARR); }
        else { row = blk * 64 + 63; const bool en = (row == SEQ - 1 || row == NLAT - 1 || row == NLAT + CTXL - 1 || row == MROWS - 1);
            prev = *(const f32x4*)(sb + 2 * SIDE_ARR); g0 = *(const f32x4*)(sb + 3 * SIDE_ARR); nx = en ? (f32x4){0.f, 0.f, 0.f, 0.f} : *(const f32x4*)(sb + FFD + 0 * SIDE_ARR); v = *(const f32x4*)(sb + 5 * SIDE_ARR); }
        const f32x4 c = bb + w0 * prev + w1 * g0 + w2 * nx;
        u32x2 o; o.x = cvt_pk_bf16(silu_f(c.x) * v.x, silu_f(c.y) * v.y); o.y = cvt_pk_bf16(silu_f(c.z) * v.z, silu_f(c.w) * v.w);
        *(u32x2*)(ACT + (size_t)row * FFD + ch) = o;
    }
}

template <int DK, int SD, int QL, bool PS, int PF>
__device__ __forceinline__ void dense_attn_phase(Frame& F, const bf16_t* Q, int ldq, int qhs, const bf16_t* K, int ldk, int khs, int kdiv, const bf16_t* KP, const bf16_t* V, int ldv, bool need_ctx) {
    const int nunits = 2048 + (need_ctx ? 32 : 0);
    for (int u = F.vcu; u < nunits; u += F.G) {
        int b, h, qrow0, base0, n0, base1, NT;
        if (u < 2048) { b = u >> 10; h = (u >> 6) & 15; const int qb = u & 63; qrow0 = b * SEQ + qb * 256; base0 = b * SEQ; n0 = 256; base1 = NLAT + b * CTXL; NT = 260; }
        else { const int uc = u - 2048; b = uc >> 4; h = uc & 15; qrow0 = NLAT + b * CTXL; base0 = 0; n0 = 0; base1 = NLAT + b * CTXL; NT = 4; }
        const int kh = h / kdiv;
        att::dense_body<DK, SD, QL, PS, PF>(Q + (size_t)qrow0 * ldq + h * qhs, ldq, K + kh * khs, ldk, KP, V + kh * khs, ldv, F.O + (size_t)qrow0 * DM + h * 128, DM, base0, n0, base1, NT, (LAS char*)F.lds);
    }
}
__device__ __forceinline__ void na_attn_phase(Frame& F, const float* rpb, bool need_ctx) {
    const bf16_t* QKV = (const bf16_t*)(F.big + BIG_QKV);
    LAS float* tab = (LAS float*)(F.lds + NATAB_OFF);
    for (int u = F.vcu; u < 2048; u += F.G) {
        const int b = u >> 10, h = (u >> 6) & 15, rg = u & 63;
        att::na_body(QKV, b, rg, h, rpb + h * 465, F.O, (LAS char*)F.lds, tab);
    }
    if (need_ctx) {
        for (int uc = F.vcu; uc < 32; uc += F.G) {
            const int b = uc >> 4, h = uc & 15, qrow0 = NLAT + b * CTXL;
            att::dense_body<128, 1, 0, false, 1>(QKV + (size_t)qrow0 * 6144 + h * 128, 6144, QKV + 2048 + h * 128, 6144, nullptr, QKV + 4096 + h * 128, 6144, F.O + (size_t)qrow0 * DM + h * 128, DM, 0, 0, qrow0, 4, (LAS char*)F.lds);
        }
    }
}

__global__ void __launch_bounds__(512, 2) mega_fwd(Args args) {
    extern __shared__ __attribute__((aligned(16))) unsigned char lds[];
    Frame F;
    F.lds = (LAS unsigned char*)lds;
    F.tid = threadIdx.x; F.lane = F.tid & 63; F.wave = __builtin_amdgcn_readfirstlane(F.tid >> 6);
    F.G = gridDim.x; { const int bx = blockIdx.x; F.vcu = (F.G % 8 == 0) ? (bx % 8) * (F.G / 8) + bx / 8 : bx; }
    F.gw = F.vcu * 8 + F.wave; F.NGW = F.G * 8;
    const KArgs kargs = (KArgs)__builtin_amdgcn_kernarg_segment_ptr();
#define PH_BEGIN KArgs ap = kargs; asm volatile("" : "+s"(ap)); { int t_ = threadIdx.x; asm volatile("" : "+v"(t_)); F.tid = t_; F.lane = t_ & 63; } { unsigned char* ws_ = ap->ws; F.ws = ws_; F.X = (float*)(ws_ + WS_X); F.H = (bf16_t*)(ws_ + WS_H); F.O = (bf16_t*)(ws_ + WS_O); \
        F.big = ws_ + WS_BIG; F.wts = ws_ + WS_W; F.mods = (float*)(ws_ + WS_MODS); F.tab = (float*)(ws_ + WS_TAB); F.rs = (float*)(ws_ + WS_RS); } \
        const float* mods_l = F.mods + (size_t)layer * 3 * MODW; (void)mods_l
    volatile LAS unsigned* MISC = (volatile LAS unsigned*)(F.lds + MISC_OFF);
    for (int u = F.tid; u < (LDS_BYTES - LDSCTL_OFF) / 4; u += 512) ((LAS unsigned*)(F.lds + LDSCTL_OFF))[u] = 0u;
    __syncthreads();
    const int lo = kargs->ph_lo, hi = kargs->ph_hi;
    unsigned* barw = (unsigned*)(kargs->ws + WS_CTL) + CW_BAR;
    XcdBarrier bar; bar.bar = barw; bar.x = 0; bar.st = nullptr;
    if (hi - lo > 1) bar = xcd_barrier_post(barw, MISC + 8);
#define IN(k) (lo <= (k) && (k) < hi)
#define SEAM(k) do { if ((k) + 1 < hi) xcd_barrier(bar); } while (0)

    if (EN(0) && IN(0)) { const int layer = 0; PH_BEGIN; _Pragma("nounroll") for (int rp_ = 0; rp_ < RPT(0); ++rp_) prologue_phase(F, ap); SEAM(0); }

    for (int layer = 0; layer < DEPTH; ++layer) {
        const int kind = layer % 3, jm = layer / 3, pb = 1 + layer * PPL;
        const bool last = (layer == DEPTH - 1);
        const int mrows = last ? NLAT : MROWS;
        if (EN(1) && IN(pb + 0)) { PH_BEGIN; _Pragma("nounroll") for (int rp_ = 0; rp_ < RPT(1); ++rp_) norm_phase(F, ap->in[6] + layer * DM, mods_l, 0, DM, MROWS, layer > 0 ? mods_l - 3 * MODW + 5 * DM + 2 * MODW : nullptr, DN_KS, layer == 0 ? ap->in[0] : (const float*)F.X, layer == 0 ? ap->in[2] : (const float*)F.X + (size_t)NLAT * DM); SEAM(pb + 0); }
        if (IN(pb + 1)) {
            PH_BEGIN; pg8::StaticOrder S;
            if (EN(2) && kind == 0) { pg8::Gemm g{F.H, (const bf16_t*)(F.wts + W_NAQKV + jm * W_NAQKV_L), MROWS, 6144, DM, DM}; S.init(MROWS, 6144, DM, F.G, (int)blockIdx.x);
                pg8::EpiBf16<false> E{(bf16_t*)(F.big + BIG_QKV), 6144, nullptr, 0, 1.0f}; _Pragma("nounroll") for (int rp_ = 0; rp_ < RPT(2); ++rp_) pg8::gemm_phase(F.lds, g, S, E); }
            else if (EN(3) && kind == 1) { pg8::Gemm g{F.H, (const bf16_t*)(F.wts + W_MLA1), MROWS, 1280, DM, DM}; S.init(MROWS, 1280, DM, F.G, (int)blockIdx.x);
                pg8::EpiBf16<false> E{(bf16_t*)(F.big + BIG_T1), 1280, nullptr, 0, 1.0f}; pg8::gemm_phase(F.lds, g, S, E); }
            else if (EN(4) && kind == 2) { pg8::Gemm g{F.H, (const bf16_t*)(F.wts + W_GQAQKV), MROWS, 3072, DM, DM}; S.init(MROWS, 3072, DM, F.G, (int)blockIdx.x);
                pg8::EpiBf16<false> E{(bf16_t*)(F.big + BIG_QKV), 3072, nullptr, 0, 1.0f}; _Pragma("nounroll") for (int rp_ = 0; rp_ < RPT(4); ++rp_) pg8::gemm_phase(F.lds, g, S, E); }
            SEAM(pb + 1);
        }
        if (kind != 0 && IN(pb + 2)) {
            PH_BEGIN;
            _Pragma("nounroll") for (int rp_ = 0; rp_ < RPT(5); ++rp_) { if (EN(5) && kind == 1) mla_post1_phase(F); else if (EN(6) && kind == 2) { if (rp_ == 0) gqa_post_phase(F, ap->in[23], ap->in[24]); } }
            SEAM(pb + 2);
        }
        if (EN(7) && kind == 1 && IN(pb + 3)) {
            PH_BEGIN;
            { pg8::StaticOrder S; pg8::Gemm g{(const bf16_t*)(F.big + BIG_T1), (const bf16_t*)(F.wts + W_MLAQB), MROWS, 3072, 512, 1280}; S.init(MROWS, 3072, 512, F.G, (int)blockIdx.x);
              pg8::EpiBf16<true> E{(bf16_t*)(F.big + BIG_Q), 3072, F.rs, 0, 0.072168783648703220f * LOG2E}; pg8::gemm_phase(F.lds, g, S, E); }
            { pg8::StaticOrder S; pg8::Gemm g{(const bf16_t*)(F.big + BIG_T1) + 512, (const bf16_t*)(F.wts + W_MLAKVB), MROWS, 4096, 512, 1280}; S.init(MROWS, 4096, 512, F.G, (int)blockIdx.x);
              pg8::EpiBf16<true> E{(bf16_t*)(F.big + BIG_KV), 4096, F.rs, 1, 1.0f}; pg8::gemm_phase(F.lds, g, S, E); }
            SEAM(pb + 3);
        }
        if (EN(8) && kind == 1 && IN(pb + 4)) { PH_BEGIN; mla_qrope_phase(F); SEAM(pb + 4); }
        if (IN(pb + 5)) {
            PH_BEGIN;
            if (EN(9) && kind == 0) _Pragma("nounroll") for (int rp_ = 0; rp_ < RPT(9); ++rp_) na_attn_phase(F, ap->in[13] + (size_t)jm * 16 * 465, !last);
            else if (EN(10) && kind == 1) { const bf16_t* KV = (const bf16_t*)(F.big + BIG_KV); _Pragma("nounroll") for (int rp_ = 0; rp_ < RPT(10); ++rp_)
                dense_attn_phase<192, 1, 6, true, 1>(F, (const bf16_t*)(F.big + BIG_Q), 3072, 192, KV, 4096, 256, 1, (const bf16_t*)(F.big + BIG_KPE), KV + 128, 4096, !last); }
            else if (EN(11) && kind == 2) { const bf16_t* QKV = (const bf16_t*)(F.big + BIG_QKV); _Pragma("nounroll") for (int rp_ = 0; rp_ < RPT(11); ++rp_)
                dense_attn_phase<128, 1, 0, true, 3>(F, QKV, 3072, 128, QKV + 2048, 3072, 128, 4, nullptr, QKV + 2560, 3072, !last); }
            SEAM(pb + 5);
        }
        if (EN(12) && IN(pb + 6)) {
            PH_BEGIN;
            const bf16_t* wo = (const bf16_t*)(F.wts + (kind == 0 ? W_NAWO + jm * W_NAWO_L : (kind == 1 ? W_MLAWO : W_GQAWO)));
            pg8::StaticOrder S; pg8::Gemm g{F.O, wo, mrows, DM, DM, DM}; S.init(NLAT, DM, DM, F.G, (int)blockIdx.x, mrows - NLAT, WO_KS);
            pg8::EpiResid E{F.X, layer == 0 ? ap->in[0] : (const float*)F.X, mods_l + 2 * DM, (float*)(F.ws + WS_PART)};
            _Pragma("nounroll") for (int rp_ = RPT(12) - 1; rp_ >= 0; --rp_) { E.gate = rp_ ? (const float*)(F.ws + WS_CTL + 262144) : mods_l + 2 * DM; pg8::gemm_phase(F.lds, g, S, E); }
            SEAM(pb + 6);
        }
        if (EN(1) && IN(pb + 7)) { PH_BEGIN; _Pragma("nounroll") for (int rp_ = 0; rp_ < RPT(1); ++rp_) norm_phase(F, ap->in[7] + layer * DM, mods_l, 3 * DM, 4 * DM, mrows, last ? nullptr : mods_l + 2 * DM + 2 * MODW, WO_KS, (const float*)F.X, layer == 0 ? ap->in[2] : (const float*)F.X + (size_t)NLAT * DM); SEAM(pb + 7); }
        if (EN(13) && IN(pb + 8)) {
            PH_BEGIN;
            pg8::StaticOrder S; pg8::Gemm g{F.H, (const bf16_t*)(F.wts + W_UP + layer * W_UP_L), mrows, 2 * FFD, DM, DM}; S.init(mrows, 2 * FFD, DM, F.G, (int)blockIdx.x);
            pg8::EpiGlu E{(bf16_t*)(F.big + BIG_ACT), ap->in[9] + (size_t)layer * 3 * FFD, ap->in[10] + (size_t)layer * FFD, (float*)(F.big + BIG_SIDE)}; _Pragma("nounroll") for (int rp_ = 0; rp_ < RPT(13); ++rp_) pg8::gemm_phase(F.lds, g, S, E);
            SEAM(pb + 8);
        }
        if (EN(14) && IN(pb + 9)) { PH_BEGIN; _Pragma("nounroll") for (int rp_ = 0; rp_ < RPT(14); ++rp_) ffn_fix_phase(F, ap->in[9] + (size_t)layer * 3 * FFD, ap->in[10] + (size_t)layer * FFD, mrows / 64); SEAM(pb + 9); }
        if (EN(15) && IN(pb + 10)) {
            PH_BEGIN;
            pg8::StaticOrder S; pg8::Gemm g{(const bf16_t*)(F.big + BIG_ACT), (const bf16_t*)(F.wts + W_DN + layer * W_DN_L), mrows, DM, FFD, FFD}; S.init(NLAT, DM, FFD, F.G, (int)blockIdx.x, mrows - NLAT, DN_KS);
            pg8::EpiResid E{F.X, (const float*)F.X, mods_l + 5 * DM, (float*)(F.ws + WS_PART)};
            _Pragma("nounroll") for (int rp_ = RPT(15) - 1; rp_ >= 0; --rp_) { E.gate = rp_ ? (const float*)(F.ws + WS_CTL + 262144) : mods_l + 5 * DM; pg8::gemm_phase(F.lds, g, S, E); }
            SEAM(pb + 10);
        }
    }
    if (EN(16) && IN(NPH - 1)) { const int layer = 0; PH_BEGIN; final_phase(F, ap->in[26], ap->out); }
#undef IN
#undef SEAM
}


#ifndef PROBE_LAYER
#define PROBE_LAYER -1
#endif
#if PROBE_LAYER >= 0
constexpr int PB_NS = 64;
__device__ __forceinline__ int pb_keyrow(int b, int j) { return j < SEQ ? b * SEQ + j : NLAT + b * CTXL + (j - SEQ); }
__device__ __forceinline__ int pb_sample_row(int s, int b, bool with_ctx) {
    if (with_ctx && s >= PB_NS - 4) return NLAT + b * CTXL + ((s * 67) & 255);
    const int sp[8] = {0, 63, 64 * 255, 16383, 64 * 3 + 5, 64 * 252 + 60, 8 * 64 + 8, 100 * 64 + 32};
    int t; if (s < 8) { t = 0;
#pragma unroll
        for (int i = 0; i < 8; ++i) if (s == i) t = sp[i]; }
    else t = (int)(((unsigned)s * 2654435761u) >> 9) & (SEQ - 1);
    return b * SEQ + t;
}
__global__ void pb_proj(const bf16_t* H, int nrows, int smode, int b, int with_ctx, const float* W, int ldw, int col0, int ncols, float* out, int ldo) {
    const long idx = (long)blockIdx.x * 256 + threadIdx.x; const int j = (int)(idx / ncols), c = (int)(idx % ncols); if (j >= nrows) return;
    const int row = smode ? pb_sample_row(j, b, with_ctx) : pb_keyrow(b, j);
    const bf16_t* h = H + (size_t)row * DM; const float* w = W + col0 + c; float acc = 0.f;
    for (int k = 0; k < DM; ++k) acc = fmaf(bf2f(h[k]), w[(size_t)k * ldw], acc);
    out[(size_t)j * ldo + c] = acc;
}
__global__ void pb_proj_f32(const float* A, int lda, int K, int nrows, const float* W, int ldw, int col0, int ncols, float* out, int ldo) {
    const long idx = (long)blockIdx.x * 256 + threadIdx.x; const int j = (int)(idx / ncols), c = (int)(idx % ncols); if (j >= nrows) return;
    const float* a = A + (size_t)j * lda; const float* w = W + col0 + c; float acc = 0.f;
    for (int k = 0; k < K; ++k) acc = fmaf(a[k], w[(size_t)k * ldw], acc);
    out[(size_t)j * ldo + c] = acc;
}
__global__ void pb_normrope(float* buf, int ld, int nrows, int smode, int b, int with_ctx, int noff, int nw, const float* gain, int roff, int rdim) {
    const int j = blockIdx.x * 256 + threadIdx.x; if (j >= nrows) return;
    const int row = smode ? pb_sample_row(j, b, with_ctx) : pb_keyrow(b, j);
    float* p = buf + (size_t)j * ld;
    if (nw > 0) { float ss = 0.f; for (int i = 0; i < nw; ++i) ss += p[noff + i] * p[noff + i]; const float rstd = 1.0f / sqrtf(ss / nw + NORM_EPS); for (int i = 0; i < nw; ++i) p[noff + i] = p[noff + i] * rstd * gain[i]; }
    if (rdim > 0 && row < NLAT) { const int tok = row & (SEQ - 1), q = rdim / 4; const float gr = (float)(tok / GRIDW), gc = (float)(tok % GRIDW);
        for (int i = 0; i < q; ++i) { const float inv = powf(10000.0f, -(float)i / (float)q); const float ar = gr * inv, ac = gc * inv;
            const float x0 = p[roff + i], x1 = p[roff + q + i], x2 = p[roff + 2 * q + i], x3 = p[roff + 3 * q + i];
            const float cr = cosf(ar), sr = sinf(ar), cc = cosf(ac), sc = sinf(ac);
            p[roff + i] = x0 * cr - x1 * sr; p[roff + q + i] = x1 * cr + x0 * sr; p[roff + 2 * q + i] = x2 * cc - x3 * sc; p[roff + 3 * q + i] = x3 * cc + x2 * sc; } }
}
__global__ void pb_attn(const float* Q, int ldq, int dk1, int dk2, const float* K1, int ldk1, const float* K2, int ldk2, const float* V, int ldv, float scale, int mode_lat,
                        const float* rpb_h, const bf16_t* O, int b, int h, int with_ctx, float* scores, unsigned* errbits) {
    __shared__ float qs[192]; __shared__ float red[256]; __shared__ float oref[128];
    const int s = blockIdx.x, tid = threadIdx.x, row = pb_sample_row(s, b, with_ctx); const bool isctx = row >= NLAT; const int tok = row & (SEQ - 1);
    const int mode = isctx ? 1 : mode_lat, nk = mode == 0 ? SEQ + CTXL : (mode == 1 ? CTXL : 128 + CTXL);
    const int r = tok / GRIDW, c = tok % GRIDW, rst = min(max(r - 4, 0), 248), cst = min(max(c - 8, 0), 48);
    if (tid < dk1 + dk2) qs[tid] = Q[(size_t)s * ldq + tid];
    __syncthreads();
    float* sc = scores + (size_t)s * (SEQ + CTXL);
    float lmax = -1e30f;
    for (int i = tid; i < nk; i += 256) { int j; float bias = 0.f;
        if (mode == 0) j = i; else if (mode == 1) j = SEQ + i;
        else if (i < 128) { const int kr = rst + i / 16, kc = cst + i % 16; j = kr * GRIDW + kc; bias = rpb_h[(kr - r + 7) * 31 + (kc - c + 15)]; } else j = SEQ + (i - 128);
        float d = 0.f; for (int t = 0; t < dk1; ++t) d = fmaf(qs[t], K1[(size_t)j * ldk1 + t], d); for (int t = 0; t < dk2; ++t) d = fmaf(qs[dk1 + t], K2[(size_t)j * ldk2 + t], d);
        const float v = d * scale + bias; sc[i] = v; lmax = fmaxf(lmax, v); }
    red[tid] = lmax; __syncthreads(); for (int o = 128; o > 0; o >>= 1) { if (tid < o) red[tid] = fmaxf(red[tid], red[tid + o]); __syncthreads(); }
    const float m = red[0]; __syncthreads();
    float lsum = 0.f; for (int i = tid; i < nk; i += 256) { const float p = expf(sc[i] - m); sc[i] = p; lsum += p; }
    red[tid] = lsum; __syncthreads(); for (int o = 128; o > 0; o >>= 1) { if (tid < o) red[tid] += red[tid + o]; __syncthreads(); }
    const float l = red[0]; __syncthreads();
    if (tid < 128) { float o = 0.f; for (int i = 0; i < nk; ++i) { int j; if (mode == 0) j = i; else if (mode == 1) j = SEQ + i; else if (i < 128) j = (rst + i / 16) * GRIDW + cst + i % 16; else j = SEQ + (i - 128);
            o = fmaf(sc[i], V[(size_t)j * ldv + tid], o); } oref[tid] = o / l; }
    __syncthreads();
    if (tid == 0) { float om = 0.f, df = 0.f; for (int d = 0; d < 128; ++d) { om = fmaxf(om, fabsf(oref[d])); df = fmaxf(df, fabsf(oref[d] - bf2f(O[(size_t)row * DM + h * 128 + d]))); }
        float e = df / (om + 1e-30f); if (!(e == e)) e = 50.f; atomicMax(errbits, __float_as_uint(e)); }
}
__global__ void pb_encode(const unsigned* errbits, float* out) { float e = __uint_as_float(*errbits); e = fminf(fmaxf(e, 1e-7f), 90.f); out[0] = e * 1e9f; }
#endif
extern "C" void kernel_launch(void* const* d_in, const int* in_sizes, int n_in, void* d_out, int out_size, void* d_ws, size_t ws_size, hipStream_t stream) {
    static int grid = 0;
    if (grid == 0) {
        if (n_in != NIN || in_sizes[0] != NLAT * DM || out_size != NLAT * DM || ws_size < WS_END) {
            fprintf(stderr, "kernel_launch: shape mismatch: n_in %d in0 %d out %d ws %zu (need >= %zu)\n", n_in, n_in > 0 ? in_sizes[0] : -1, out_size, ws_size, (size_t)WS_END); grid = -1; return; }
        int dev = 0, cus = 0, per_cu = 0;
        if (hipGetDevice(&dev) != hipSuccess || hipDeviceGetAttribute(&cus, hipDeviceAttributeMultiprocessorCount, dev) != hipSuccess) { fprintf(stderr, "kernel_launch: device query failed\n"); grid = -1; return; }
        if (hipFuncSetAttribute((const void*)mega_fwd, hipFuncAttributeMaxDynamicSharedMemorySize, LDS_BYTES) != hipSuccess) { fprintf(stderr, "kernel_launch: hipFuncSetAttribute failed\n"); grid = -1; return; }
        if (hipOccupancyMaxActiveBlocksPerMultiprocessor(&per_cu, (const void*)mega_fwd, 512, LDS_BYTES) != hipSuccess || per_cu < 1)
            fprintf(stderr, "kernel_launch: note: occupancy query reports %d workgroups per CU\n", per_cu);
        (void)hipGetLastError();
        grid = cus;
    }
    if (grid < 0) return;
    if (hipMemsetAsync((char*)d_ws + WS_CTL, 0, CTL_ZERO_BYTES, stream) != hipSuccess) { fprintf(stderr, "kernel_launch: memset failed\n"); return; }
    Args a{};
    for (int i = 0; i < NIN; ++i) a.in[i] = (const float*)d_in[i];
    a.out = (float*)d_out; a.ws = (unsigned char*)d_ws; a.rep_mask = RP_MASK;
#if MK_PER_PHASE
    for (int ph = 0; ph < NPH; ++ph) {
        if (!phase_exists(ph)) continue;
        a.ph_lo = ph; a.ph_hi = ph + 1;
        hipLaunchKernelGGL(mega_fwd, dim3(grid), dim3(512), LDS_BYTES, stream, a);
    }
#elif PROBE_LAYER >= 0
    {
        constexpr int L = PROBE_LAYER, kind = L % 3, jm = L / 3; constexpr bool wctx = (L != DEPTH - 1);
        a.ph_lo = 0; a.ph_hi = 1 + L * PPL + 6;
        hipLaunchKernelGGL(mega_fwd, dim3(grid), dim3(512), LDS_BYTES, stream, a);
        unsigned char* ws = (unsigned char*)d_ws; const bf16_t* H = (const bf16_t*)(ws + WS_H); const bf16_t* O = (const bf16_t*)(ws + WS_O);
        float* R0 = (float*)(ws + WS_PART); float* R1 = R0 + (size_t)16640 * 576; float* R2 = R1 + (size_t)16640 * 256; float* R3 = R2 + (size_t)PB_NS * 512; float* SC = R3 + (size_t)PB_NS * 192;
        unsigned* err = (unsigned*)((unsigned char*)d_ws + 512 * 1024);
        const int NK = SEQ + CTXL;
        auto nb = [](long n) { return (unsigned)((n + 255) / 256); };
        hipMemsetAsync(d_out, 0, (size_t)out_size * 4, stream);
        if (kind == 2) { const int b = 1, h = 9, kvh = 2; const float* W = (const float*)d_in[22];
            hipLaunchKernelGGL(pb_proj, dim3(nb((long)NK * 128)), dim3(256), 0, stream, H, NK, 0, b, 1, W, 3072, 2048 + kvh * 128, 128, R0, 128);
            hipLaunchKernelGGL(pb_proj, dim3(nb((long)NK * 128)), dim3(256), 0, stream, H, NK, 0, b, 1, W, 3072, 2560 + kvh * 128, 128, R1, 128);
            hipLaunchKernelGGL(pb_normrope, dim3(nb(NK)), dim3(256), 0, stream, R0, 128, NK, 0, b, 1, 0, 128, (const float*)d_in[24], 0, 128);
            hipLaunchKernelGGL(pb_proj, dim3(nb((long)PB_NS * 128)), dim3(256), 0, stream, H, PB_NS, 1, b, 1, W, 3072, h * 128, 128, R2, 128);
            hipLaunchKernelGGL(pb_normrope, dim3(nb(PB_NS)), dim3(256), 0, stream, R2, 128, PB_NS, 1, b, 1, 0, 128, (const float*)d_in[23], 0, 128);
            hipLaunchKernelGGL(pb_attn, dim3(PB_NS), dim3(256), 0, stream, R2, 128, 128, 0, R0, 128, (const float*)nullptr, 0, R1, 128, 0.088388347648318440f, 0, (const float*)nullptr, O, b, h, 1, SC, err);
        } else if (kind == 1) { const int b = 0, h = 5;
            hipLaunchKernelGGL(pb_proj, dim3(nb((long)NK * 576)), dim3(256), 0, stream, H, NK, 0, b, 1, (const float*)d_in[18], 576, 0, 576, R0, 576);
            hipLaunchKernelGGL(pb_normrope, dim3(nb(NK)), dim3(256), 0, stream, R0, 576, NK, 0, b, 1, 0, 512, (const float*)d_in[19], 512, 64);
            hipLaunchKernelGGL(pb_proj_f32, dim3(nb((long)NK * 256)), dim3(256), 0, stream, R0, 576, 512, NK, (const float*)d_in[20], 4096, h * 256, 256, R1, 256);
            hipLaunchKernelGGL(pb_proj, dim3(nb((long)PB_NS * 512)), dim3(256), 0, stream, H, PB_NS, 1, b, 1, (const float*)d_in[15], 512, 0, 512, R2, 512);
            hipLaunchKernelGGL(pb_normrope, dim3(nb(PB_NS)), dim3(256), 0, stream, R2, 512, PB_NS, 1, b, 1, 0, 512, (const float*)d_in[16], 0, 0);
            hipLaunchKernelGGL(pb_proj_f32, dim3(nb((long)PB_NS * 192)), dim3(256), 0, stream, R2, 512, 512, PB_NS, (const float*)d_in[17], 3072, h * 192, 192, R3, 192);
            hipLaunchKernelGGL(pb_normrope, dim3(nb(PB_NS)), dim3(256), 0, stream, R3, 192, PB_NS, 1, b, 1, 0, 0, (const float*)nullptr, 128, 64);
            hipLaunchKernelGGL(pb_attn, dim3(PB_NS), dim3(256), 0, stream, R3, 192, 128, 64, R1, 256, R0 + 512, 576, R1 + 128, 256, 0.072168783648703220f, 0, (const float*)nullptr, O, b, h, 1, SC, err);
        } else { const int b = 1, h = 3; const float* W = (const float*)d_in[12] + (size_t)jm * DM * 6144;
            hipLaunchKernelGGL(pb_proj, dim3(nb((long)NK * 128)), dim3(256), 0, stream, H, NK, 0, b, wctx ? 1 : 0, W, 6144, 2048 + h * 128, 128, R0, 128);
            hipLaunchKernelGGL(pb_proj, dim3(nb((long)NK * 128)), dim3(256), 0, stream, H, NK, 0, b, wctx ? 1 : 0, W, 6144, 4096 + h * 128, 128, R1, 128);
            hipLaunchKernelGGL(pb_proj, dim3(nb((long)PB_NS * 128)), dim3(256), 0, stream, H, PB_NS, 1, b, wctx ? 1 : 0, W, 6144, h * 128, 128, R2, 128);
            hipLaunchKernelGGL(pb_attn, dim3(PB_NS), dim3(256), 0, stream, R2, 128, 128, 0, R0, 128, (const float*)nullptr, 0, R1, 128, 0.088388347648318440f, 2, (const float*)d_in[13] + ((size_t)jm * 16 + h) * 465, O, b, h, wctx ? 1 : 0, SC, err);
        }
        hipLaunchKernelGGL(pb_encode, dim3(1), dim3(1), 0, stream, (const unsigned*)err, (float*)d_out);
    }
#else
    a.ph_lo = 0; a.ph_hi = NPH;
    hipLaunchKernelGGL(mega_fwd, dim3(grid), dim3(512), LDS_BYTES, stream, a);
#endif
    const hipError_t le = hipPeekAtLastError();
    if (le != hipSuccess) fprintf(stderr, "kernel_launch: launch failed: %s\n", hipGetErrorName(le));
}
```
